# Optimizing an MI355X kernel written in HIP

```python
import jax, jax.numpy as jnp
from jax import lax
import numpy as np

D_MODEL = 1024
BATCH = 16
SEQ = 2048
DEPTH = 2

BLOCK = 128
EPS = 1e-6
ROPE_BASE = 10000.0
MLA_HEADS = 8
MLA_NOPE = 64
MLA_ROPE = 32
MLA_V = 64
MLA_Q_RANK = 384
MLA_KV_RANK = 256
RET_HEADS = 8
RET_DK = 64
RET_DV = 128
SWA_HEADS = 16
SWA_KV_HEADS = 2
SWA_DIM = 64
WINDOW = 128
SB_HEADS = 8
SB_DIM = 64
D_FF = 3584
N_EXPERTS = 8
TOP_K = 2
MOE_BLOCK = 256

AB_SPLITS = (MLA_Q_RANK, MLA_KV_RANK, MLA_ROPE, RET_HEADS * RET_DK, RET_HEADS * RET_DK, RET_HEADS * RET_DV, RET_HEADS * RET_DV)
AB_IN = sum(AB_SPLITS)
AB_MIX = MLA_HEADS * MLA_V + RET_HEADS * RET_DV
CD_SPLITS = (SWA_HEADS * SWA_DIM, SWA_KV_HEADS * SWA_DIM, SWA_KV_HEADS * SWA_DIM, SB_HEADS * SB_DIM, SB_HEADS * SB_DIM, SB_HEADS * SB_DIM)
CD_IN = sum(CD_SPLITS)
CD_MIX = SWA_HEADS * SWA_DIM + SB_HEADS * SB_DIM

kernel_name = "hybrid_mla_retention_swa_stickbreak_moe"


def _split(x, sizes):
    return jnp.split(x, [int(i) for i in np.cumsum(sizes)[:-1]], axis=-1)


def _rmsnorm(x, g):
    xf = x.astype(jnp.float32)
    y = xf * lax.rsqrt(jnp.mean(xf * xf, axis=-1, keepdims=True) + EPS)
    return (y * g.astype(jnp.float32)).astype(x.dtype)


def _rope(x, pos):
    half = x.shape[-1] // 2
    inv_freq = ROPE_BASE ** (-jnp.arange(half, dtype=jnp.float32) / half)
    ang = pos.astype(jnp.float32)[:, None] * inv_freq[None, :]
    cos = jnp.cos(ang)[:, None, :]
    sin = jnp.sin(ang)[:, None, :]
    xf = x.astype(jnp.float32)
    x1, x2 = xf[..., :half], xf[..., half:]
    return jnp.concatenate([x1 * cos - x2 * sin, x1 * sin + x2 * cos], axis=-1).astype(x.dtype)


def _to_blocks(t):
    B, S = t.shape[:2]
    return jnp.moveaxis(t.reshape((B, S // BLOCK, BLOCK) + t.shape[2:]), 1, 0)


def _from_blocks(t):
    t = jnp.moveaxis(t, 0, 1)
    return t.reshape((t.shape[0], t.shape[1] * t.shape[2]) + t.shape[3:])


def _causal_softmax_attention(q, k, v):
    S = q.shape[1]
    scale = q.shape[-1] ** -0.5
    kpos = jnp.arange(S)

    def block(args):
        qi, i = args
        s = jnp.einsum('bqhd,bkhd->bhqk', qi, k, preferred_element_type=jnp.float32) * scale
        qpos = i * BLOCK + jnp.arange(BLOCK)
        s = jnp.where(kpos[None, :] <= qpos[:, None], s, -jnp.inf)
        p = jax.nn.softmax(s, axis=-1)
        return jnp.einsum('bhqk,bkhd->bqhd', p.astype(v.dtype), v)

    return _from_blocks(lax.map(block, (_to_blocks(q), jnp.arange(S // BLOCK))))


def _retention(q, k, v):
    B, S, H, dk = q.shape
    dv = v.shape[-1]
    log_gamma = jnp.log1p(-(2.0 ** (-5.0 - jnp.arange(H, dtype=jnp.float32))))
    idx = jnp.arange(BLOCK, dtype=jnp.float32)
    rel = idx[:, None] - idx[None, :]
    decay_in = jnp.where(rel >= 0, jnp.exp(log_gamma[:, None, None] * jnp.maximum(rel, 0.0)), 0.0)
    q_decay = jnp.exp(log_gamma[:, None] * (idx + 1.0))
    k_decay = jnp.exp(log_gamma[:, None] * (BLOCK - 1.0 - idx))
    chunk_decay = jnp.exp(log_gamma * BLOCK)
    qc = _to_blocks(q.astype(jnp.float32))
    kc = _to_blocks(k.astype(jnp.float32)) * (dk ** -0.5)
    vc = _to_blocks(v.astype(jnp.float32))
    inner = jnp.einsum('nbqhd,nbkhd->nbhqk', qc, kc) * decay_in[None, None]
    out_inner = jnp.einsum('nbhqk,nbkhv->nbqhv', inner, vc)
    kv_chunk = jnp.einsum('nbkhd,hk,nbkhv->nbhdv', kc, k_decay, vc)

    def step(state, kv):
        return state * chunk_decay[None, :, None, None] + kv, state

    _, prev = lax.scan(step, jnp.zeros((B, H, dk, dv), jnp.float32), kv_chunk)
    out_cross = jnp.einsum('nbqhd,hq,nbhdv->nbqhv', qc, q_decay, prev)
    return _from_blocks(out_inner + out_cross)


def _head_groupnorm(y, g):
    B, S, H, dv = y.shape
    mu = jnp.mean(y, axis=-1, keepdims=True)
    var = jnp.mean(jnp.square(y - mu), axis=-1, keepdims=True)
    yn = (y - mu) * lax.rsqrt(var + EPS)
    return yn.reshape(B, S, H * dv) * g.astype(jnp.float32)


def _mixer_mla_retention(h, w_in, q_norm, w_uq, kv_norm, w_ukv, ret_gn, w_out):
    B, S, _ = h.shape
    pos = jnp.arange(S)
    q_lat, kv_lat, k_rope, rq, rk, rv, rg = _split(h @ w_in, AB_SPLITS)
    qh = (_rmsnorm(q_lat, q_norm) @ w_uq).reshape(B, S, MLA_HEADS, MLA_NOPE + MLA_ROPE)
    kvh = (_rmsnorm(kv_lat, kv_norm) @ w_ukv).reshape(B, S, MLA_HEADS, MLA_NOPE + MLA_V)
    q = jnp.concatenate([qh[..., :MLA_NOPE], _rope(qh[..., MLA_NOPE:], pos)], axis=-1)
    k_pe = jnp.broadcast_to(_rope(k_rope[:, :, None, :], pos), (B, S, MLA_HEADS, MLA_ROPE))
    k = jnp.concatenate([kvh[..., :MLA_NOPE], k_pe], axis=-1)
    mla = _causal_softmax_attention(q, k, kvh[..., MLA_NOPE:]).reshape(B, S, MLA_HEADS * MLA_V)
    ret = _retention(_rope(rq.reshape(B, S, RET_HEADS, RET_DK), pos),
                     _rope(rk.reshape(B, S, RET_HEADS, RET_DK), pos),
                     rv.reshape(B, S, RET_HEADS, RET_DV))
    ret = jax.nn.silu(rg.astype(jnp.float32)) * _head_groupnorm(ret, ret_gn)
    mixed = jnp.concatenate([mla, ret.astype(h.dtype)], axis=-1)
    return mixed @ w_out


def _alibi_slopes(n):
    return 2.0 ** (-8.0 * jnp.arange(1, n + 1, dtype=jnp.float32) / n)


def _sliding_window_sink_attention(q, k, v, sinks):
    B, S, HQ, d = q.shape
    HKV = k.shape[2]
    G = HQ // HKV
    nb = S // WINDOW
    scale = d ** -0.5

    def band(t):
        tb = t.reshape(B, nb, WINDOW, HKV, d)
        prev = jnp.pad(tb, ((0, 0), (1, 0), (0, 0), (0, 0), (0, 0)))[:, :-1]
        return jnp.moveaxis(jnp.concatenate([prev, tb], axis=2), 1, 0)

    qb = jnp.moveaxis(q.reshape(B, nb, WINDOW, HKV, G, d), 1, 0)
    slopes = _alibi_slopes(HQ).reshape(HKV, G)[:, :, None, None]
    sink = sinks.astype(jnp.float32).reshape(HKV, G)[None, :, :, None, None]
    dist = jnp.arange(WINDOW)[:, None] + WINDOW - jnp.arange(2 * WINDOW)[None, :]
    in_window = (dist >= 0) & (dist < WINDOW)
    dist_f = dist.astype(jnp.float32)

    def block(args):
        qi, ki, vi, i = args
        s = jnp.einsum('bqhgd,bkhd->bhgqk', qi, ki, preferred_element_type=jnp.float32) * scale - slopes * dist_f
        valid = in_window & (((i - 1) * WINDOW + jnp.arange(2 * WINDOW)) >= 0)[None, :]
        s = jnp.where(valid, s, -jnp.inf)
        m = jnp.maximum(jnp.max(s, axis=-1, keepdims=True), sink)
        p = jnp.exp(s - m)
        p = p / (jnp.sum(p, axis=-1, keepdims=True) + jnp.exp(sink - m))
        return jnp.einsum('bhgqk,bkhd->bqhgd', p.astype(vi.dtype), vi)

    out = lax.map(block, (qb, band(k), band(v), jnp.arange(nb)))
    return jnp.moveaxis(out, 0, 1).reshape(B, S, HQ * d)


def _stick_breaking_attention(q, k, v):
    S = q.shape[1]
    scale = q.shape[-1] ** -0.5
    kpos = jnp.arange(S)

    def block(args):
        qi, i = args
        z = jnp.einsum('bqhd,bkhd->bhqk', qi, k, preferred_element_type=jnp.float32) * scale
        qpos = i * BLOCK + jnp.arange(BLOCK)
        before = kpos[None, :] < qpos[:, None]
        log_keep = jnp.where(before, jax.nn.log_sigmoid(-z), 0.0)
        log_after = lax.cumsum(log_keep, axis=3, reverse=True) - log_keep
        a = jnp.where(before, jnp.exp(jax.nn.log_sigmoid(z) + log_after), 0.0)
        return jnp.einsum('bhqk,bkhd->bqhd', a.astype(v.dtype), v)

    return _from_blocks(lax.map(block, (_to_blocks(q), jnp.arange(S // BLOCK))))


def _mixer_swa_stickbreak(h, w_in, sinks, w_out):
    B, S, _ = h.shape
    sq, sk, sv, bq, bk, bv = _split(h @ w_in, CD_SPLITS)
    swa = _sliding_window_sink_attention(sq.reshape(B, S, SWA_HEADS, SWA_DIM),
                                         sk.reshape(B, S, SWA_KV_HEADS, SWA_DIM),
                                         sv.reshape(B, S, SWA_KV_HEADS, SWA_DIM), sinks)
    sb = _stick_breaking_attention(bq.reshape(B, S, SB_HEADS, SB_DIM),
                                   bk.reshape(B, S, SB_HEADS, SB_DIM),
                                   bv.reshape(B, S, SB_HEADS, SB_DIM)).reshape(B, S, SB_HEADS * SB_DIM)
    return jnp.concatenate([swa, sb], axis=-1) @ w_out


def _swiglu(h, w_gate, w_up, w_down):
    return (jax.nn.silu(h @ w_gate) * (h @ w_up)) @ w_down


def _moe(h, router, w_gate, w_up, w_down):
    B, S, D = h.shape
    T = B * S
    TK = T * TOP_K
    xf = h.reshape(T, D)
    logits = (xf @ router).astype(jnp.float32)
    top_logits, top_idx = lax.top_k(logits, TOP_K)
    gates = jax.nn.softmax(top_logits, axis=-1)
    expert = top_idx.reshape(-1).astype(jnp.int32)
    token = jnp.repeat(jnp.arange(T, dtype=jnp.int32), TOP_K)
    gate = gates.reshape(-1)
    order = jnp.argsort(expert)
    se, st, sg = expert[order], token[order], gate[order]
    counts = jnp.zeros((N_EXPERTS,), jnp.int32).at[expert].add(1)
    padded = ((counts + MOE_BLOCK - 1) // MOE_BLOCK) * MOE_BLOCK
    pad_end = jnp.cumsum(padded)
    pad_start = pad_end - padded
    grp_start = jnp.cumsum(counts) - counts
    dest = pad_start[se] + (jnp.arange(TK, dtype=jnp.int32) - grp_start[se])
    cap = -(-TK // MOE_BLOCK) * MOE_BLOCK + N_EXPERTS * MOE_BLOCK
    nblk = cap // MOE_BLOCK
    buf_tok = jnp.zeros((cap,), jnp.int32).at[dest].set(st)
    buf_gate = jnp.zeros((cap,), jnp.float32).at[dest].set(sg)
    blk_start = jnp.arange(nblk, dtype=jnp.int32) * MOE_BLOCK
    blk_exp = jnp.minimum(jnp.searchsorted(pad_end, blk_start, side='right'), N_EXPERTS - 1)
    xg = xf[buf_tok].reshape(nblk, MOE_BLOCK, D)

    def expert_block(args):
        xb, e = args
        return (jax.nn.silu(xb @ w_gate[e]) * (xb @ w_up[e])) @ w_down[e]

    yg = lax.map(expert_block, (xg, blk_exp)).reshape(cap, D)
    out = jnp.zeros((T, D), h.dtype).at[buf_tok].add((yg * buf_gate[:, None]).astype(h.dtype))
    return out.reshape(B, S, D)


def setup_inputs(seed: int = 0) -> dict:
    key = jax.random.key(seed)
    ks = iter(jax.random.split(key, 32))
    NE = (DEPTH + 1) // 2
    NO = DEPTH // 2

    def w(shape, fan_in):
        return jax.random.normal(next(ks), shape, jnp.float32) * (fan_in ** -0.5)

    def gain(shape):
        return 1.0 + 0.02 * jax.random.normal(next(ks), shape, jnp.float32)

    return {
        'x': jax.random.normal(next(ks), (BATCH, SEQ, D_MODEL), jnp.float32),
        'ab_norm': gain((NE, D_MODEL)),
        'ab_w_in': w((NE, D_MODEL, AB_IN), D_MODEL),
        'mla_q_norm': gain((NE, MLA_Q_RANK)),
        'mla_w_uq': w((NE, MLA_Q_RANK, MLA_HEADS * (MLA_NOPE + MLA_ROPE)), MLA_Q_RANK),
        'mla_kv_norm': gain((NE, MLA_KV_RANK)),
        'mla_w_ukv': w((NE, MLA_KV_RANK, MLA_HEADS * (MLA_NOPE + MLA_V)), MLA_KV_RANK),
        'ret_gn': gain((NE, RET_HEADS * RET_DV)),
        'ab_w_out': w((NE, AB_MIX, D_MODEL), AB_MIX),
        'ffn_norm': gain((NE, D_MODEL)),
        'ffn_w_gate': w((NE, D_MODEL, D_FF), D_MODEL),
        'ffn_w_up': w((NE, D_MODEL, D_FF), D_MODEL),
        'ffn_w_down': w((NE, D_FF, D_MODEL), D_FF),
        'cd_norm': gain((NO, D_MODEL)),
        'cd_w_in': w((NO, D_MODEL, CD_IN), D_MODEL),
        'swa_sinks': 0.5 * jax.random.normal(next(ks), (NO, SWA_HEADS), jnp.float32),
        'cd_w_out': w((NO, CD_MIX, D_MODEL), CD_MIX),
        'moe_norm': gain((NO, D_MODEL)),
        'moe_router': w((NO, D_MODEL, N_EXPERTS), D_MODEL),
        'moe_w_gate': w((NO, N_EXPERTS, D_MODEL, D_FF), D_MODEL),
        'moe_w_up': w((NO, N_EXPERTS, D_MODEL, D_FF), D_MODEL),
        'moe_w_down': w((NO, N_EXPERTS, D_FF, D_MODEL), D_FF),
        'final_norm': gain((D_MODEL,)),
    }


def reference(x, ab_norm, ab_w_in, mla_q_norm, mla_w_uq, mla_kv_norm, mla_w_ukv, ret_gn, ab_w_out,
              ffn_norm, ffn_w_gate, ffn_w_up, ffn_w_down, cd_norm, cd_w_in, swa_sinks, cd_w_out,
              moe_norm, moe_router, moe_w_gate, moe_w_up, moe_w_down, final_norm):
    h = x
    for layer in range(DEPTH):
        i = layer // 2
        if layer % 2 == 0:
            h = h + _mixer_mla_retention(_rmsnorm(h, ab_norm[i]), ab_w_in[i], mla_q_norm[i], mla_w_uq[i],
                                         mla_kv_norm[i], mla_w_ukv[i], ret_gn[i], ab_w_out[i])
            h = h + _swiglu(_rmsnorm(h, ffn_norm[i]), ffn_w_gate[i], ffn_w_up[i], ffn_w_down[i])
        else:
            h = h + _mixer_swa_stickbreak(_rmsnorm(h, cd_norm[i]), cd_w_in[i], swa_sinks[i], cd_w_out[i])
            h = h + _moe(_rmsnorm(h, moe_norm[i]), moe_router[i], moe_w_gate[i], moe_w_up[i], moe_w_down[i])
    return _rmsnorm(h, final_norm)
```

```cpp
#include <hip/hip_runtime.h>
#include <cstdio>
#include <cstdint>
#include <cmath>

__device__ __forceinline__ void sincos_rev(double f, float& sn, float& cs) {
    const int k = (int)(f * 4.0 + 0.5); const double r = f - 0.25 * (double)k; const double a = 6.283185307179586476925 * r; const double a2 = a * a;
    double s = a * (1.0 + a2 * (-1.0 / 6 + a2 * (1.0 / 120 + a2 * (-1.0 / 5040 + a2 * (1.0 / 362880 + a2 * (-1.0 / 39916800 + a2 * (1.0 / 6227020800.0)))))));
    double c = 1.0 + a2 * (-0.5 + a2 * (1.0 / 24 + a2 * (-1.0 / 720 + a2 * (1.0 / 40320 + a2 * (-1.0 / 3628800 + a2 * (1.0 / 479001600.0 + a2 * (-1.0 / 87178291200.0)))))));
    const int q = k & 3; double so, co;
    if (q == 0) { so = s; co = c; } else if (q == 1) { so = c; co = -s; } else if (q == 2) { so = -s; co = -c; } else { so = -c; co = s; }
    sn = (float)so; cs = (float)co;
}
__device__ __forceinline__ void rope_cs(int pos, int i, int half, float& sn, float& cs) {
    const double r = (half == 16) ? 0.5623413251903491 : 0.7498942093324559;
    double inv = 1.0; for (int j = 0; j < i; ++j) inv *= r;
    const double rev = (double)pos * inv * 0.15915494309189533577; const double fl = (double)(long long)rev;
    sincos_rev(rev - fl, sn, cs);
}
namespace nv {
constexpr int S = 2048, DM = 1024, NB = 16;
constexpr int AB_IN = 3744, CD_IN = 2816, FF = 3584, NE = 8;
constexpr float EPSN = 1e-6f;

__global__ void __launch_bounds__(256) k_rmsnorm(const float* x, int ldx, const float* __restrict__ g, float* y, int ldy, int n) {
    const int r = blockIdx.x; const float* xr = x + (size_t)r * ldx; float* yr = y + (size_t)r * ldy;
    __shared__ float red[256];
    float s = 0.f; for (int i = threadIdx.x; i < n; i += 256) { float v = xr[i]; s += v * v; }
    red[threadIdx.x] = s; __syncthreads();
    for (int o = 128; o > 0; o >>= 1) { if (threadIdx.x < o) red[threadIdx.x] += red[threadIdx.x + o]; __syncthreads(); }
    const float rs = 1.0f / sqrtf(red[0] / (float)n + EPSN);
    for (int i = threadIdx.x; i < n; i += 256) yr[i] = xr[i] * rs * g[i];
}

__global__ void __launch_bounds__(256) k_gemm(const float* __restrict__ A, int lda, const float* __restrict__ B, int ldb, float* __restrict__ C, int ldc,
                       int M, int N, int K, const int* __restrict__ gather, const int* __restrict__ mcnt, int mode) {
    __shared__ float As[16][65];
    __shared__ float Bs[16][65];
    const int Mv = mcnt ? *mcnt : M;
    const int m0 = blockIdx.y * 64, n0 = blockIdx.x * 64;
    if (m0 >= Mv) return;
    const int tx = threadIdx.x & 15, ty = threadIdx.x >> 4;
    float acc[4][4];
#pragma unroll
    for (int i = 0; i < 4; ++i)
#pragma unroll
        for (int j = 0; j < 4; ++j) acc[i][j] = 0.f;
    for (int k0 = 0; k0 < K; k0 += 16) {
#pragma unroll
        for (int i = 0; i < 4; ++i) {
            const int e = threadIdx.x + i * 256; const int mm = e >> 4, kk = e & 15;
            const int m = m0 + mm; float v = 0.f;
            if (m < Mv && (k0 + kk) < K) { const int ar = gather ? gather[m] : m; v = A[(size_t)ar * lda + k0 + kk]; }
            As[kk][mm] = v;
        }
#pragma unroll
        for (int i = 0; i < 4; ++i) {
            const int e = threadIdx.x + i * 256; const int kk = e >> 6, nn = e & 63;
            const int n = n0 + nn; float v = 0.f;
            if (n < N && (k0 + kk) < K) v = B[(size_t)(k0 + kk) * ldb + n];
            Bs[kk][nn] = v;
        }
        __syncthreads();
#pragma unroll
        for (int kk = 0; kk < 16; ++kk) {
            float a[4], b[4];
#pragma unroll
            for (int i = 0; i < 4; ++i) a[i] = As[kk][ty * 4 + i];
#pragma unroll
            for (int j = 0; j < 4; ++j) b[j] = Bs[kk][tx * 4 + j];
#pragma unroll
            for (int i = 0; i < 4; ++i)
#pragma unroll
                for (int j = 0; j < 4; ++j) acc[i][j] += a[i] * b[j];
        }
        __syncthreads();
    }
#pragma unroll
    for (int i = 0; i < 4; ++i) {
        const int m = m0 + ty * 4 + i; if (m >= Mv) continue;
#pragma unroll
        for (int j = 0; j < 4; ++j) { const int n = n0 + tx * 4 + j; if (n >= N) continue;
            float* c = C + (size_t)m * ldc + n; if (mode == 1) *c += acc[i][j]; else *c = acc[i][j]; }
    }
}

__global__ void __launch_bounds__(256) k_rope(float* __restrict__ x, int ld, int c0, int nh, int d, int rows) {
    const int half = d / 2; const int total = rows * nh * half;
    const int idx = blockIdx.x * blockDim.x + threadIdx.x; if (idx >= total) return;
    const int i = idx % half, h = (idx / half) % nh, r = idx / (half * nh);
    float c, s; rope_cs(r, i, half, s, c);
    float* p = x + (size_t)r * ld + c0 + h * d;
    const float x1 = p[i], x2 = p[i + half];
    p[i] = x1 * c - x2 * s; p[i + half] = x1 * s + x2 * c;
}

__global__ void __launch_bounds__(64) k_mla(const float* __restrict__ q, const float* __restrict__ kvh, const float* __restrict__ kpe, int ldp, float* __restrict__ mixed, int ldm) {
    const int idx = blockIdx.x * blockDim.x + threadIdx.x; if (idx >= S * 8) return;
    const int s = idx % S, h = idx / S;
    float qv[96];
#pragma unroll
    for (int i = 0; i < 96; ++i) qv[i] = q[(size_t)s * 768 + h * 96 + i];
    float acc[64];
#pragma unroll
    for (int i = 0; i < 64; ++i) acc[i] = 0.f;
    float m = -INFINITY, l = 0.f; const float scale = 1.0f / sqrtf(96.f);
    for (int k = 0; k <= s; ++k) {
        const float* kr = kvh + (size_t)k * 1024 + h * 128; const float* pr = kpe + (size_t)k * ldp;
        float d = 0.f;
#pragma unroll
        for (int i = 0; i < 64; ++i) d += qv[i] * kr[i];
#pragma unroll
        for (int i = 0; i < 32; ++i) d += qv[64 + i] * pr[i];
        d *= scale;
        const float mn = fmaxf(m, d); const float f = expf(m - mn), p = expf(d - mn);
        l = l * f + p;
#pragma unroll
        for (int i = 0; i < 64; ++i) acc[i] = acc[i] * f + p * kr[64 + i];
        m = mn;
    }
    const float il = 1.0f / l;
#pragma unroll
    for (int i = 0; i < 64; ++i) mixed[(size_t)s * ldm + h * 64 + i] = acc[i] * il;
}

__global__ void __launch_bounds__(64) k_ret(const float* __restrict__ P, int ldp, int crq, int crk, int crv, float* __restrict__ ret) {
    const int idx = blockIdx.x * blockDim.x + threadIdx.x; if (idx >= S * 8 * 2) return;
    const int t = idx % S, hh = idx / S, h = hh >> 1, half = hh & 1;
    float qv[64];
#pragma unroll
    for (int i = 0; i < 64; ++i) qv[i] = P[(size_t)t * ldp + crq + h * 64 + i];
    float acc[64];
#pragma unroll
    for (int i = 0; i < 64; ++i) acc[i] = 0.f;
    const float lg = log1pf(-exp2f(-5.0f - (float)h));
    for (int s = 0; s <= t; ++s) {
        const float* kr = P + (size_t)s * ldp + crk + h * 64; const float* vr = P + (size_t)s * ldp + crv + h * 128 + half * 64;
        float d = 0.f;
#pragma unroll
        for (int i = 0; i < 64; ++i) d += qv[i] * kr[i];
        d *= 0.125f * expf(lg * (float)(t - s));
#pragma unroll
        for (int i = 0; i < 64; ++i) acc[i] += d * vr[i];
    }
#pragma unroll
    for (int i = 0; i < 64; ++i) ret[(size_t)t * 1024 + h * 128 + half * 64 + i] = acc[i];
}
__global__ void __launch_bounds__(256) k_ret_gn(const float* __restrict__ ret, const float* __restrict__ P, int ldp, int crg, const float* __restrict__ gn, float* __restrict__ mixed, int ldm) {
    const int idx = blockIdx.x * blockDim.x + threadIdx.x; if (idx >= S * 8) return;
    const int t = idx / 8, h = idx % 8; const float* y = ret + (size_t)t * 1024 + h * 128;
    float mu = 0.f; for (int i = 0; i < 128; ++i) mu += y[i]; mu /= 128.f;
    float var = 0.f; for (int i = 0; i < 128; ++i) { const float d = y[i] - mu; var += d * d; } var /= 128.f;
    const float rs = 1.0f / sqrtf(var + EPSN);
    for (int i = 0; i < 128; ++i) { const float g = P[(size_t)t * ldp + crg + h * 128 + i]; const float sg = g / (1.0f + expf(-g));
        mixed[(size_t)t * ldm + 512 + h * 128 + i] = sg * ((y[i] - mu) * rs * gn[h * 128 + i]); }
}
__global__ void __launch_bounds__(256) k_swiglu(const float* __restrict__ g, const float* __restrict__ u, float* __restrict__ o, size_t n, const int* cnt, int rowlen) {
    const size_t nn = cnt ? (size_t)(*cnt) * rowlen : n;
    for (size_t i = (size_t)blockIdx.x * blockDim.x + threadIdx.x; i < nn; i += (size_t)gridDim.x * blockDim.x) { const float a = g[i]; o[i] = a / (1.0f + expf(-a)) * u[i]; }
}
__global__ void __launch_bounds__(256) k_copy(const float* __restrict__ a, float* __restrict__ o, size_t n) {
    for (size_t i = (size_t)blockIdx.x * blockDim.x + threadIdx.x; i < n; i += (size_t)gridDim.x * blockDim.x) o[i] = a[i];
}
__global__ void __launch_bounds__(64) k_swa(const float* __restrict__ P, int ldp, const float* __restrict__ sinks, float* __restrict__ mixed, int ldm) {
    const int idx = blockIdx.x * blockDim.x + threadIdx.x; if (idx >= S * 16) return;
    const int t = idx % S, hq = idx / S, hkv = hq / 8;
    const float slope = exp2f(-8.0f * (float)(hq + 1) / 16.0f), sink = sinks[hq];
    float qv[64];
#pragma unroll
    for (int i = 0; i < 64; ++i) qv[i] = P[(size_t)t * ldp + hq * 64 + i];
    float acc[64];
#pragma unroll
    for (int i = 0; i < 64; ++i) acc[i] = 0.f;
    float m = sink, l = 1.0f;
    const int lo = t - 127 < 0 ? 0 : t - 127;
    for (int k = lo; k <= t; ++k) {
        const float* kr = P + (size_t)k * ldp + 1024 + hkv * 64; const float* vr = P + (size_t)k * ldp + 1152 + hkv * 64;
        float d = 0.f;
#pragma unroll
        for (int i = 0; i < 64; ++i) d += qv[i] * kr[i];
        d = d * 0.125f - slope * (float)(t - k);
        const float mn = fmaxf(m, d); const float f = expf(m - mn), p = expf(d - mn);
        l = l * f + p;
#pragma unroll
        for (int i = 0; i < 64; ++i) acc[i] = acc[i] * f + p * vr[i];
        m = mn;
    }
    const float il = 1.0f / l;
#pragma unroll
    for (int i = 0; i < 64; ++i) mixed[(size_t)t * ldm + hq * 64 + i] = acc[i] * il;
}
__global__ void __launch_bounds__(64) k_sb(const float* __restrict__ P, int ldp, float* __restrict__ mixed, int ldm) {
    const int idx = blockIdx.x * blockDim.x + threadIdx.x; if (idx >= S * 8) return;
    const int t = idx % S, h = idx / S;
    float qv[64];
#pragma unroll
    for (int i = 0; i < 64; ++i) qv[i] = P[(size_t)t * ldp + 1280 + h * 64 + i];
    float acc[64];
#pragma unroll
    for (int i = 0; i < 64; ++i) acc[i] = 0.f;
    float run = 0.f;
    for (int k = t - 1; k >= 0; --k) {
        const float* kr = P + (size_t)k * ldp + 1792 + h * 64; const float* vr = P + (size_t)k * ldp + 2304 + h * 64;
        float z = 0.f;
#pragma unroll
        for (int i = 0; i < 64; ++i) z += qv[i] * kr[i];
        z *= 0.125f;
        const float sp = fmaxf(z, 0.f) + log1pf(expf(-fabsf(z)));
        const float a = expf(z - sp - run);
#pragma unroll
        for (int i = 0; i < 64; ++i) acc[i] += a * vr[i];
        run += sp;
    }
#pragma unroll
    for (int i = 0; i < 64; ++i) mixed[(size_t)t * ldm + 1024 + h * 64 + i] = acc[i];
}
__global__ void __launch_bounds__(64) k_route(const float* __restrict__ hn, const float* __restrict__ router, int* __restrict__ tope, float* __restrict__ topg, int n) {
    const int t = blockIdx.x * blockDim.x + threadIdx.x; if (t >= n) return;
    float lg[8];
#pragma unroll
    for (int e = 0; e < 8; ++e) lg[e] = 0.f;
    for (int k = 0; k < DM; ++k) { const float v = hn[(size_t)t * DM + k];
#pragma unroll
        for (int e = 0; e < 8; ++e) lg[e] += v * router[k * 8 + e]; }
    int e0 = 0; float b0 = lg[0];
#pragma unroll
    for (int e = 1; e < 8; ++e) if (lg[e] > b0) { b0 = lg[e]; e0 = e; }
    int e1 = -1; float b1 = -INFINITY;
#pragma unroll
    for (int e = 0; e < 8; ++e) if (e != e0 && lg[e] > b1) { b1 = lg[e]; e1 = e; }
    const float p1 = expf(b1 - b0); const float g0 = 1.0f / (1.0f + p1), g1 = p1 / (1.0f + p1);
    tope[t * 2] = e0; tope[t * 2 + 1] = e1; topg[t * 2] = g0; topg[t * 2 + 1] = g1;
}
__global__ void __launch_bounds__(256) k_list(const int* __restrict__ tope, const float* __restrict__ topg, int e, int* __restrict__ cnt, int* __restrict__ list, float* __restrict__ listg, int n) {
    const int t = blockIdx.x * blockDim.x + threadIdx.x; if (t >= n) return;
    for (int k = 0; k < 2; ++k) if (tope[t * 2 + k] == e) { const int p = atomicAdd(cnt, 1); list[p] = t; listg[p] = topg[t * 2 + k]; }
}
__global__ void __launch_bounds__(256) k_scatter(const float* __restrict__ y, const int* __restrict__ list, const float* __restrict__ listg, const int* __restrict__ cnt, float* __restrict__ h) {
    const int r = blockIdx.x; if (r >= *cnt) return;
    const int t = list[r]; const float g = listg[r];
    for (int i = threadIdx.x; i < DM; i += blockDim.x) h[(size_t)t * DM + i] += g * y[(size_t)r * DM + i];
}

struct In { const float *x, *ab_norm, *ab_w_in, *q_norm, *w_uq, *kv_norm, *w_ukv, *ret_gn, *ab_w_out, *ffn_norm, *ffn_wg, *ffn_wu, *ffn_wd,
            *cd_norm, *cd_w_in, *sinks, *cd_w_out, *moe_norm, *router, *moe_wg, *moe_wu, *moe_wd, *final_norm; };

inline void gemm(hipStream_t st, const float* A, int lda, const float* B, int ldb, float* C, int ldc, int M, int N, int K, const int* gather = nullptr, const int* mcnt = nullptr, int mode = 0) {
    dim3 g((N + 63) / 64, (M + 63) / 64);
    hipLaunchKernelGGL(k_gemm, g, dim3(256), 0, st, A, lda, B, ldb, C, ldc, M, N, K, gather, mcnt, mode);
}

inline void run(hipStream_t st, const In& I, float* hout, unsigned char* ws, int b_lo, int b_hi, float* chk1, float* chk2, float* chk3, bool final_norm_inplace) {
    float* p = (float*)ws;
    float* xn = p;  p += (size_t)S * DM;
    float* P = p;   p += (size_t)S * AB_IN;
    float* qn = p;  p += (size_t)S * 384;
    float* kvn = p; p += (size_t)S * 256;
    float* q = p;   p += (size_t)S * 768;
    float* kvh = p; p += (size_t)S * 1024;
    float* ret = p; p += (size_t)S * 1024;
    float* mixed = p; p += (size_t)S * 1536;
    float* ag = p;  p += (size_t)S * FF;
    float* au = p;  p += (size_t)S * FF;
    float* y = p;   p += (size_t)S * DM;
    float* topg = p; p += (size_t)S * 2;
    float* listg = p; p += (size_t)S * 2;
    int* tope = (int*)p; p += (size_t)S * 2;
    int* list = (int*)p; p += (size_t)S * 2;
    int* cnt = (int*)p; p += 64;
    for (int b = b_lo; b < b_hi; ++b) {
        const float* xb = I.x + (size_t)b * S * DM; float* hb = hout + (size_t)b * S * DM;
        hipLaunchKernelGGL(k_rmsnorm, dim3(S), dim3(256), 0, st, xb, DM, I.ab_norm, xn, DM, DM);
        gemm(st, xn, DM, I.ab_w_in, AB_IN, P, AB_IN, S, AB_IN, DM);
        hipLaunchKernelGGL(k_rmsnorm, dim3(S), dim3(256), 0, st, P + 0, AB_IN, I.q_norm, qn, 384, 384);
        hipLaunchKernelGGL(k_rmsnorm, dim3(S), dim3(256), 0, st, P + 384, AB_IN, I.kv_norm, kvn, 256, 256);
        gemm(st, qn, 384, I.w_uq, 768, q, 768, S, 768, 384);
        gemm(st, kvn, 256, I.w_ukv, 1024, kvh, 1024, S, 1024, 256);
        for (int h = 0; h < 8; ++h) hipLaunchKernelGGL(k_rope, dim3((S * 16 + 255) / 256), dim3(256), 0, st, q, 768, h * 96 + 64, 1, 32, S);
        hipLaunchKernelGGL(k_rope, dim3((S * 16 + 255) / 256), dim3(256), 0, st, P, AB_IN, 640, 1, 32, S);
        hipLaunchKernelGGL(k_rope, dim3((S * 8 * 32 + 255) / 256), dim3(256), 0, st, P, AB_IN, 672, 8, 64, S);
        hipLaunchKernelGGL(k_rope, dim3((S * 8 * 32 + 255) / 256), dim3(256), 0, st, P, AB_IN, 1184, 8, 64, S);
        hipLaunchKernelGGL(k_mla, dim3(S * 8 / 64), dim3(64), 0, st, q, kvh, P + 640, AB_IN, mixed, 1536);
        hipLaunchKernelGGL(k_ret, dim3(S * 16 / 64), dim3(64), 0, st, P, AB_IN, 672, 1184, 1696, ret);
        hipLaunchKernelGGL(k_ret_gn, dim3(S * 8 / 256), dim3(256), 0, st, ret, P, AB_IN, 2720, I.ret_gn, mixed, 1536);
        hipLaunchKernelGGL(k_copy, dim3(1024), dim3(256), 0, st, xb, hb, (size_t)S * DM);
        gemm(st, mixed, 1536, I.ab_w_out, DM, hb, DM, S, DM, 1536, nullptr, nullptr, 1);
        if (chk1) hipLaunchKernelGGL(k_copy, dim3(1024), dim3(256), 0, st, hb, chk1 + (size_t)b * S * DM, (size_t)S * DM);
        hipLaunchKernelGGL(k_rmsnorm, dim3(S), dim3(256), 0, st, hb, DM, I.ffn_norm, xn, DM, DM);
        gemm(st, xn, DM, I.ffn_wg, FF, ag, FF, S, FF, DM);
        gemm(st, xn, DM, I.ffn_wu, FF, au, FF, S, FF, DM);
        hipLaunchKernelGGL(k_swiglu, dim3(2048), dim3(256), 0, st, ag, au, ag, (size_t)S * FF, (const int*)nullptr, FF);
        gemm(st, ag, FF, I.ffn_wd, DM, hb, DM, S, DM, FF, nullptr, nullptr, 1);
        if (chk2) hipLaunchKernelGGL(k_copy, dim3(1024), dim3(256), 0, st, hb, chk2 + (size_t)b * S * DM, (size_t)S * DM);
        hipLaunchKernelGGL(k_rmsnorm, dim3(S), dim3(256), 0, st, hb, DM, I.cd_norm, xn, DM, DM);
        gemm(st, xn, DM, I.cd_w_in, CD_IN, P, CD_IN, S, CD_IN, DM);
        hipLaunchKernelGGL(k_swa, dim3(S * 16 / 64), dim3(64), 0, st, P, CD_IN, I.sinks, mixed, 1536);
        hipLaunchKernelGGL(k_sb, dim3(S * 8 / 64), dim3(64), 0, st, P, CD_IN, mixed, 1536);
        gemm(st, mixed, 1536, I.cd_w_out, DM, hb, DM, S, DM, 1536, nullptr, nullptr, 1);
        if (chk3) hipLaunchKernelGGL(k_copy, dim3(1024), dim3(256), 0, st, hb, chk3 + (size_t)b * S * DM, (size_t)S * DM);
        hipLaunchKernelGGL(k_rmsnorm, dim3(S), dim3(256), 0, st, hb, DM, I.moe_norm, xn, DM, DM);
        hipLaunchKernelGGL(k_route, dim3(S / 64), dim3(64), 0, st, xn, I.router, tope, topg, S);
        for (int e = 0; e < NE; ++e) {
            hipMemsetAsync(cnt, 0, 4, st);
            hipLaunchKernelGGL(k_list, dim3(S / 256), dim3(256), 0, st, tope, topg, e, cnt, list, listg, S);
            const float* wg = I.moe_wg + (size_t)e * DM * FF; const float* wu = I.moe_wu + (size_t)e * DM * FF; const float* wd = I.moe_wd + (size_t)e * FF * DM;
            gemm(st, xn, DM, wg, FF, ag, FF, S, FF, DM, list, cnt);
            gemm(st, xn, DM, wu, FF, au, FF, S, FF, DM, list, cnt);
            hipLaunchKernelGGL(k_swiglu, dim3(2048), dim3(256), 0, st, ag, au, ag, (size_t)0, (const int*)cnt, FF);
            gemm(st, ag, FF, wd, DM, y, DM, S, DM, FF, nullptr, cnt);
            hipLaunchKernelGGL(k_scatter, dim3(S), dim3(256), 0, st, y, list, listg, cnt, hb);
        }
        if (final_norm_inplace) hipLaunchKernelGGL(k_rmsnorm, dim3(S), dim3(256), 0, st, hb, DM, I.final_norm, hb, DM, DM);
    }
}
}

extern "C" void kernel_launch(void* const* d_in, const int* in_sizes, int n_in, void* d_out, int out_size, void* d_ws, size_t ws_size, hipStream_t stream) {
    nv::In I;
    const float** f = (const float**)&I;
    for (int i = 0; i < 23; ++i) f[i] = (const float*)d_in[i];
    nv::run(stream, I, (float*)d_out, (unsigned char*)d_ws, 0, 16, nullptr, nullptr, nullptr, true);
}
```

```cpp
#include <hip/hip_runtime.h>
#include <cstdio>
#include <cstdint>
#include <cmath>
__device__ __forceinline__ void sincos_rev(double f, float& sn, float& cs) {
    const int k = (int)(f * 4.0 + 0.5); const double r = f - 0.25 * (double)k; const double a = 6.283185307179586476925 * r; const double a2 = a * a;
    double s = a * (1.0 + a2 * (-1.0 / 6 + a2 * (1.0 / 120 + a2 * (-1.0 / 5040 + a2 * (1.0 / 362880 + a2 * (-1.0 / 39916800 + a2 * (1.0 / 6227020800.0)))))));
    double c = 1.0 + a2 * (-0.5 + a2 * (1.0 / 24 + a2 * (-1.0 / 720 + a2 * (1.0 / 40320 + a2 * (-1.0 / 3628800 + a2 * (1.0 / 479001600.0 + a2 * (-1.0 / 87178291200.0)))))));
    const int q = k & 3; double so, co;
    if (q == 0) { so = s; co = c; } else if (q == 1) { so = c; co = -s; } else if (q == 2) { so = -s; co = -c; } else { so = -c; co = s; }
    sn = (float)so; cs = (float)co;
}
__device__ __forceinline__ void rope_cs(int pos, int i, int half, float& sn, float& cs) {
    const double r = (half == 16) ? 0.5623413251903491 : 0.7498942093324559;
    double inv = 1.0; for (int j = 0; j < i; ++j) inv *= r;
    const double rev = (double)pos * inv * 0.15915494309189533577; const double fl = (double)(long long)rev;
    sincos_rev(rev - fl, sn, cs);
}
#define GAS __attribute__((address_space(1)))
#define LAS __attribute__((address_space(3)))
#define DI __device__ __forceinline__
typedef unsigned short bf16;
typedef short bf16x8 __attribute__((ext_vector_type(8)));
typedef float f32x4 __attribute__((ext_vector_type(4)));
typedef float f32x16 __attribute__((ext_vector_type(16)));
typedef unsigned u32x4 __attribute__((ext_vector_type(4)));
typedef unsigned u32x2 __attribute__((ext_vector_type(2)));
typedef float f32x2_t __attribute__((ext_vector_type(2)));
typedef __bf16 bf16x2_t __attribute__((ext_vector_type(2)));
typedef GAS unsigned gu32;
#define RLX_AGENT __ATOMIC_RELAXED, __HIP_MEMORY_SCOPE_AGENT
DI unsigned pk2(float lo, float hi) { f32x2_t v = {lo, hi}; bf16x2_t b = __builtin_convertvector(v, bf16x2_t); return __builtin_bit_cast(unsigned, b); }
DI float bf_lo(unsigned u) { return __builtin_bit_cast(float, u << 16); }
DI float bf_hi(unsigned u) { return __builtin_bit_cast(float, u & 0xffff0000u); }
DI float wave_sum(float v) {
#pragma unroll
    for (int o = 1; o < 64; o <<= 1) v += __shfl_xor(v, o);
    return v;
}

#define XB_TMO      128
#define XB_XCNT(j)  (256  + 64 * (j))
#define XB_XSUB(j)  (1280 + 64 * (j))
#define XB_XGEN(j)  (2304 + 64 * (j))
#define XB_TOP      3328
#define XB_TOPGEN   3392
#define XCD_BAR_WORDS 3456
#define XB_SPIN_CAP (1u << 18)

__device__ __forceinline__ unsigned xb_ld(unsigned* p)              { return __hip_atomic_load(p, __ATOMIC_RELAXED, __HIP_MEMORY_SCOPE_AGENT); }
__device__ __forceinline__ unsigned xb_add(unsigned* p, unsigned v) { return __hip_atomic_fetch_add(p, v, __ATOMIC_RELAXED, __HIP_MEMORY_SCOPE_AGENT); }
__device__ __forceinline__ unsigned xb_xcc_id() { return (unsigned)__builtin_amdgcn_s_getreg((3 << 11) | 20) & 0xFu; }
#define XB_SPIN(cond, bar) do { unsigned _sp = 0; while (cond) { __builtin_amdgcn_s_sleep(1); \
    if ((++_sp & 255u) == 0u) { if (xb_ld(&(bar)[XB_TMO])) break; if (_sp > XB_SPIN_CAP) { atomicAdd(&(bar)[XB_TMO], 1u); break; } } } } while (0)

struct XcdBarrier {
    unsigned* bar; unsigned x;
    volatile LAS unsigned* st;
};

__device__ __forceinline__ XcdBarrier xcd_barrier_post(unsigned* bar, volatile LAS unsigned* st) {
    XcdBarrier b; b.bar = bar; b.x = xb_xcc_id(); b.st = st;
    if (threadIdx.x == 0) (void)xb_add(&bar[XB_XCNT(b.x)], 1u);
    return b;
}
__device__ __forceinline__ void xcd_barrier_complete(unsigned* bar, unsigned x, unsigned& nloc, unsigned& nx) {
    const unsigned G = gridDim.x * gridDim.y * gridDim.z;
    unsigned sum, cnt, mine, sp = 0u;
    for (;;) {
        sum = 0u; cnt = 0u; mine = 0u;
#pragma unroll
        for (unsigned j = 0; j < 16; ++j) { const unsigned c = xb_ld(&bar[XB_XCNT(j)]); sum += c; cnt += (c > 0u) ? 1u : 0u; mine = (j == x) ? c : mine; }
        if (sum == G) break;
        __builtin_amdgcn_s_sleep(1);
        if ((++sp & 255u) == 0u) { if (xb_ld(&bar[XB_TMO])) break; if (sp > XB_SPIN_CAP) { atomicAdd(&bar[XB_TMO], 1u); break; } }
    }
    nloc = mine > 0u ? mine : 1u; nx = cnt > 0u ? cnt : 1u;
}

__device__ __forceinline__ void xcd_barrier(const XcdBarrier& b) {
    asm volatile("s_waitcnt vmcnt(0)" ::: "memory");
    __syncthreads();
    if (threadIdx.x == 0) {
        unsigned* bar = b.bar;
        __builtin_amdgcn_s_waitcnt(0);
        unsigned nloc = b.st[0], nx = b.st[1];
        if (nloc == 0u) { xcd_barrier_complete(bar, b.x, nloc, nx); b.st[0] = nloc; b.st[1] = nx; }
        const unsigned old = xb_add(&bar[XB_XSUB(b.x)], 1u);
        const unsigned gen = old / nloc;
        if (old + 1u == (gen + 1u) * nloc) {
            __builtin_amdgcn_fence(__ATOMIC_RELEASE, "agent");
            asm volatile("s_waitcnt vmcnt(0)" ::: "memory");
            const unsigned og = xb_add(&bar[XB_TOP], 1u);
            const unsigned tg = og / nx;
            if (og + 1u == (tg + 1u) * nx) xb_add(&bar[XB_TOPGEN], 1u);
            else XB_SPIN(xb_ld(&bar[XB_TOPGEN]) == tg, bar);
            __builtin_amdgcn_fence(__ATOMIC_ACQUIRE, "agent");
            xb_add(&bar[XB_XGEN(b.x)], 1u);
            asm volatile("s_waitcnt vmcnt(0)" ::: "memory");
        } else {
            XB_SPIN(xb_ld(&bar[XB_XGEN(b.x)]) == gen, bar);
            __builtin_amdgcn_fence(__ATOMIC_ACQUIRE, "agent");
            asm volatile("s_waitcnt vmcnt(0)" ::: "memory");
        }
    }
    __syncthreads();
}


namespace pg8 {
#define PG8_LAS __attribute__((address_space(3)))
typedef unsigned short bf16_t;
constexpr int BM = 256, BK = 64, HALF = 128, HTB = HALF * BK * 2  , STAGE_BYTES = 8 * HTB;
__host__ __device__ __forceinline__ int lds_byte(int r, int c) { const int st = (r >> 4) * 2 + (c >> 5), rr = r & 15, cc = c & 31, ob = rr * 64 + cc * 2; return st * 1024 + (ob ^ (((ob >> 9) & 1) << 5)); }
__host__ __device__ __forceinline__ void stage_rc(int b, int& R, int& C) { const int st = b / 1024, sb = b % 1024, swz = sb ^ (((sb >> 9) & 1) << 5); R = (st >> 1) * 16 + swz / 64; C = (st & 1) * 32 + (swz % 64) / 2; }
__host__ __device__ __forceinline__ int perm32(int rho) { const int n = rho >> 4, i = rho & 15; return 8 * (i >> 2) + 4 * n + (i & 3); }

struct Unit { int pm, pn, om, on, ex; };
struct Gemm { const bf16_t* A; const bf16_t* Bt; int lda, ldb, K; const unsigned* slot_tok; };

struct StaticOrder {
    int nM, nN, nwg, G, c;
    __device__ void init(int M, int N, int G_, int c_) { nM = M / BM; nN = N / BM; nwg = nM * nN; G = G_; c = c_; }
    __device__ bool next(int i, Unit& u) const {
        const long L = (long)i * G + c; if (L >= nwg) return false;
        int wgid = (int)L; { const int q = nwg / 8, r = nwg % 8, xcd = wgid % 8, off = wgid / 8; wgid = (xcd < r ? xcd * (q + 1) : r * (q + 1) + (xcd - r) * q) + off; }
        const int nig = 8 * nN, gid = wgid / nig, fm = gid * 8, gsz = (nM - fm) < 8 ? (nM - fm) : 8;
        u.pm = fm + ((wgid % nig) % gsz); u.pn = (wgid % nig) / gsz; u.om = u.pm; u.on = u.pn; u.ex = 0; return true;
    }
};

template <class Epi, class Sched, bool GATHER>
__device__ __forceinline__ void gemm_phase(PG8_LAS unsigned char* lds, const Gemm g, const Sched& S, const Epi& E) {
    const int tid = threadIdx.x, wid = __builtin_amdgcn_readfirstlane(tid >> 6), lane = tid & 63, wr = wid >> 2, wc = wid & 3, fr = lane & 15, fq = lane >> 4;
    const int K = g.K, nt = K / BK;
    unsigned voffA[2], voffB[2];
#pragma unroll
    for (int i = 0; i < 2; ++i) { int R, C; stage_rc(tid * 16 + i * 8192, R, C); const int Rb = (R & ~31) + perm32(R & 31);
        voffA[i] = (unsigned)(R * g.lda + C) * 2u; voffB[i] = (unsigned)(Rb * g.ldb + C) * 2u; }
    const size_t kstep = (size_t)(BK * 2);
    const size_t hstepB = (size_t)HALF * g.ldb * 2, tstepB = 2 * hstepB;
    const size_t hstepA = GATHER ? (size_t)0 : (size_t)HALF * g.lda * 2, tstepA = 2 * hstepA;
    const unsigned ldsw = (unsigned)wid * 1024u;
    const int aoff = lds_byte(wr * 64 + fr, fq * 8), boff = lds_byte(wc * 32 + fr, fq * 8);
#define PG8_SA(b, h) (((b) * 2 + (h)) * HTB)
#define PG8_SB(b, h) ((4 + (b) * 2 + (h)) * HTB)
#define PG8_STAGE_B(bufoff, gbase) do { _Pragma("unroll") for (int _i = 0; _i < 2; ++_i) \
        __builtin_amdgcn_global_load_lds((const unsigned*)((const char*)(gbase) + voffB[_i]), (PG8_LAS unsigned*)(lds + (bufoff) + ldsw + _i * 8192), 16, 0, 0); } while (0)
#define PG8_STAGE_A(bufoff, gbase, h) do { _Pragma("unroll") for (int _i = 0; _i < 2; ++_i) \
        __builtin_amdgcn_global_load_lds((const unsigned*)((const char*)(gbase) + (size_t)(h) * hstepA + (GATHER ? vC[h][_i] : voffA[_i])), (PG8_LAS unsigned*)(lds + (bufoff) + ldsw + _i * 8192), 16, 0, 0); } while (0)
#define PG8_SETV(V, u) do { _Pragma("unroll") for (int _h = 0; _h < 2; ++_h) _Pragma("unroll") for (int _i = 0; _i < 2; ++_i) { int _R, _C; stage_rc(tid * 16 + _i * 8192, _R, _C); \
        const unsigned _s = g.slot_tok[(size_t)(u).pm * 256 + _h * 128 + _R]; const unsigned _t = _s ? ((_s - 1u) >> 1) : 0u; (V)[_h][_i] = (_t * (unsigned)g.lda + (unsigned)_C) * 2u; } } while (0)
#define PG8_LDA(dst, b, h) do { _Pragma("unroll") for (int m = 0; m < 4; ++m) _Pragma("unroll") for (int k = 0; k < 2; ++k) dst[m][k] = *(const PG8_LAS bf16x8*)(lds + PG8_SA(b, h) + aoff + m * 2048 + k * 1024); } while (0)
#define PG8_LDB(dst, b, h) do { _Pragma("unroll") for (int n = 0; n < 2; ++n) _Pragma("unroll") for (int k = 0; k < 2; ++k) dst[n][k] = *(const PG8_LAS bf16x8*)(lds + PG8_SB(b, h) + boff + n * 2048 + k * 1024); } while (0)
#define PG8_MMA(ai, bj, At, Bt) do { __builtin_amdgcn_s_setprio(1); _Pragma("unroll") for (int m = 0; m < 4; ++m) _Pragma("unroll") for (int n = 0; n < 2; ++n) _Pragma("unroll") for (int k = 0; k < 2; ++k) \
        acc[ai][bj][m][n] = __builtin_amdgcn_mfma_f32_16x16x32_bf16(Bt[n][k], At[m][k], acc[ai][bj][m][n], 0, 0, 0); __builtin_amdgcn_s_setprio(0); } while (0)
#define PG8_WAIT_V(n) asm volatile("s_waitcnt vmcnt(" #n ")" ::: "memory")
#define PG8_WAIT_L(n) asm volatile("s_waitcnt lgkmcnt(" #n ")" ::: "memory")
#define PG8_BAR __builtin_amdgcn_s_barrier()
#define PG8_SCHED __builtin_amdgcn_sched_barrier(0)
    Unit cur, nxt; int ui = 0;
    if (!S.next(0, cur)) return;
    f32x4 acc[2][2][4][2];
#pragma unroll
    for (int a = 0; a < 2; ++a)
#pragma unroll
        for (int b = 0; b < 2; ++b)
#pragma unroll
            for (int m = 0; m < 4; ++m)
#pragma unroll
                for (int n = 0; n < 2; ++n) acc[a][b][m][n] = (f32x4){0.f, 0.f, 0.f, 0.f};
    bf16x8 At[4][2], B0[2][2], B1[2][2];
    unsigned vC[2][2], vN[2][2];
    if (GATHER) { PG8_SETV(vC, cur); }
    const char* cA = (const char*)g.A + (size_t)cur.pm * tstepA; const char* cB = (const char*)g.Bt + (size_t)cur.pn * tstepB;
    PG8_STAGE_B(PG8_SB(0, 0), cB); PG8_STAGE_B(PG8_SB(0, 1), cB + hstepB); PG8_STAGE_A(PG8_SA(0, 0), cA, 0); PG8_STAGE_A(PG8_SA(0, 1), cA, 1);
    if (wr == 1) PG8_BAR;
    PG8_WAIT_V(2); PG8_BAR;
    PG8_STAGE_B(PG8_SB(1, 0), cB + kstep); PG8_STAGE_A(PG8_SA(1, 0), cA + kstep, 0); PG8_STAGE_B(PG8_SB(1, 1), cB + hstepB + kstep);
    PG8_WAIT_V(6); PG8_BAR;
    for (;;) {
        const bool has_next = S.next(ui + 1, nxt);
        const char* nA = has_next ? (const char*)g.A + (size_t)nxt.pm * tstepA : cA; const char* nB = has_next ? (const char*)g.Bt + (size_t)nxt.pn * tstepB : cB;
        if (GATHER) {
            if (has_next) { PG8_SETV(vN, nxt); }
            else {
#pragma unroll
                for (int _h = 0; _h < 2; ++_h)
#pragma unroll
                    for (int _i = 0; _i < 2; ++_i) vN[_h][_i] = vC[_h][_i];
            }
        }
#pragma clang loop unroll(disable)
        for (int t = 0; t < nt; t += 2) {
            const bool last = (t == nt - 2);
            const char* a1 = cA + (size_t)(t + 1) * kstep;
            const char* a2 = last ? nA : cA + (size_t)(t + 2) * kstep; const char* b2 = last ? nB : cB + (size_t)(t + 2) * kstep;
            const char* a3 = a2 + kstep; const char* b3 = b2 + kstep;
            PG8_LDB(B0, 0, 0); PG8_LDB(B1, 0, 1); PG8_SCHED; PG8_LDA(At, 0, 0); PG8_STAGE_A(PG8_SA(1, 1), a1, 1);
            if (GATHER && last) {
#pragma unroll
                for (int _h = 0; _h < 2; ++_h)
#pragma unroll
                    for (int _i = 0; _i < 2; ++_i) vC[_h][_i] = vN[_h][_i];
            }
            PG8_WAIT_V(8); PG8_WAIT_L(0); PG8_BAR; PG8_MMA(0, 0, At, B0); PG8_MMA(0, 1, At, B1); PG8_BAR; PG8_SCHED;
            PG8_LDA(At, 0, 1); PG8_STAGE_B(PG8_SB(0, 0), b2); PG8_STAGE_B(PG8_SB(0, 1), b2 + hstepB); PG8_STAGE_A(PG8_SA(0, 0), a2, 0);
            PG8_WAIT_V(8); PG8_WAIT_L(0); PG8_BAR; PG8_MMA(1, 0, At, B0); PG8_MMA(1, 1, At, B1); PG8_BAR; PG8_SCHED;
            PG8_LDB(B0, 1, 0); PG8_LDB(B1, 1, 1); PG8_SCHED; PG8_LDA(At, 1, 0); PG8_STAGE_A(PG8_SA(0, 1), a2, 1);
            PG8_WAIT_V(8); PG8_WAIT_L(0); PG8_BAR; PG8_MMA(0, 0, At, B0); PG8_MMA(0, 1, At, B1); PG8_BAR; PG8_SCHED;
            PG8_LDA(At, 1, 1); PG8_STAGE_B(PG8_SB(1, 0), b3); PG8_STAGE_B(PG8_SB(1, 1), b3 + hstepB); PG8_STAGE_A(PG8_SA(1, 0), a3, 0);
            PG8_WAIT_V(8); PG8_WAIT_L(0); PG8_BAR; PG8_MMA(1, 0, At, B0); PG8_MMA(1, 1, At, B1); PG8_BAR; PG8_SCHED;
        }
        if (wr == 0) PG8_BAR;
        E(acc, cur, wr, wc, fr, fq);
        if (!has_next) break;
#pragma unroll
        for (int a = 0; a < 2; ++a)
#pragma unroll
            for (int b = 0; b < 2; ++b)
#pragma unroll
                for (int m = 0; m < 4; ++m)
#pragma unroll
                    for (int n = 0; n < 2; ++n) acc[a][b][m][n] = (f32x4){0.f, 0.f, 0.f, 0.f};
        cur = nxt; cA = nA; cB = nB; ++ui;
        if (wr == 1) PG8_BAR;
    }
    PG8_WAIT_V(0);
    PG8_BAR;
#undef PG8_SA
#undef PG8_SB
#undef PG8_STAGE_A
#undef PG8_STAGE_B
#undef PG8_SETV
#undef PG8_LDA
#undef PG8_LDB
#undef PG8_MMA
#undef PG8_WAIT_V
#undef PG8_WAIT_L
#undef PG8_BAR
#undef PG8_SCHED
}
}
namespace fk {
using pg8::Unit; using pg8::Gemm;
constexpr int NWAVES = 8, NTHR = 512;
constexpr int SEQ = 2048, NBATCH = 16, T = NBATCH * SEQ, DM = 1024, FF = 3584, NEXP = 8;
constexpr int AB_IN = 3744, AB_P = 3840;
constexpr int CD_IN = 2816;
constexpr int PC_QLAT = 0, PC_KVLAT = 384, PC_KROPE = 640, PC_RQ = 768, PC_RK = 1280, PC_RV = 1792, PC_RG = 2816;
constexpr int P2_SQ = 0, P2_SK = 1024, P2_SV = 1152, P2_BQ = 1280, P2_BK = 1792, P2_BV = 2304;
constexpr float EPS = 1e-6f;
constexpr float LOG2E = 1.4426950408889634f;
constexpr int MOE_CAP = 2 * T + NEXP * 256;
constexpr int CHUNK_PANELS = 64;

constexpr size_t MiB = 1u << 20;
constexpr size_t WS_CTL = 0, CTL_ZERO_BYTES = 1 * MiB;
constexpr size_t WS_TAB = 1 * MiB;
constexpr size_t WS_CS16 = WS_TAB, WS_CS32 = WS_TAB + 262144;
constexpr size_t WS_W = 2 * MiB;
constexpr size_t WS_W_ABIN = WS_W;
constexpr size_t WS_W_UQ = WS_W_ABIN + (size_t)AB_P * 1024 * 2;
constexpr size_t WS_W_UKV = WS_W_UQ + (size_t)768 * 384 * 2;
constexpr size_t WS_W_ABOUT = WS_W_UKV + (size_t)1024 * 256 * 2;
constexpr size_t WS_W_FGU = WS_W_ABOUT + (size_t)1024 * 1536 * 2;
constexpr size_t WS_W_FD = WS_W_FGU + (size_t)7168 * 1024 * 2;
constexpr size_t WS_W_CDIN = WS_W_FD + (size_t)1024 * 3584 * 2;
constexpr size_t WS_W_CDOUT = WS_W_CDIN + (size_t)2816 * 1024 * 2;
constexpr size_t WS_W_END = WS_W_CDOUT + (size_t)1024 * 1536 * 2;
static_assert(WS_W_END <= 44 * MiB, "small weights fit [2,44) MiB");
constexpr size_t WS_ACT = 44 * MiB;
constexpr size_t WS_P = WS_ACT;
constexpr size_t WS_XN = 284 * MiB;
constexpr size_t WS_KVH = 284 * MiB;
constexpr size_t WS_Q = 348 * MiB;
constexpr size_t WS_MIXED = 396 * MiB;
constexpr size_t WS_HACT = WS_ACT;
constexpr size_t WS_P2 = WS_ACT;
constexpr size_t WS_MIXED2 = 220 * MiB;
constexpr size_t WS_MACT = WS_ACT;
constexpr size_t WS_XN3 = 156 * MiB;
constexpr size_t WS_YBUF = 220 * MiB;
constexpr size_t WS_MOEW = 377 * MiB;
constexpr size_t WS_MOEW_GU = WS_MOEW, WS_MOEW_D = WS_MOEW + (size_t)NEXP * 7168 * 1024 * 2;
constexpr size_t WS_END = WS_MOEW_D + (size_t)NEXP * 1024 * 3584 * 2;
static_assert(WS_END == 545 * MiB, "ws map end");
constexpr int CW_TMO = 0, CW_CODE = 1;
constexpr int CW_QUEUE = 64;
constexpr int CW_ECNT = 1024;
constexpr int CW_BAR = 4096;
constexpr int CW_SLOT_TOK = 65536;
constexpr int CW_SLOT_GATE = CW_SLOT_TOK + MOE_CAP;
static_assert((size_t)(CW_SLOT_GATE + MOE_CAP) * 4 <= CTL_ZERO_BYTES, "ctl fits");
static_assert(CW_BAR + 16 * 3456 <= CW_SLOT_TOK, "barrier regions");

constexpr int RING_BYTES = 131072;
constexpr int MISC_OFF = RING_BYTES;
constexpr int LDS_BYTES = 147456;

struct Frame {
    LAS unsigned char* lds;
    volatile LAS unsigned* MISC;
    gu32* ctl;
    unsigned char* ws;
    int wave, G, bid;
    float* out;
};
struct Args { const float* in[23]; float* out; unsigned char* ws; int ph_lo, ph_hi, li, pad; };

struct EpiBf16 {
    bf16* O; int ldc;
    DI void operator()(const f32x4 (&acc)[2][2][4][2], const Unit& u, int wr, int wc, int fr, int fq) const {
        const int row0 = u.om * 256 + wr * 64 + fr, col0 = u.on * 256 + wc * 32 + 8 * fq;
#pragma unroll
        for (int ai = 0; ai < 2; ++ai)
#pragma unroll
            for (int m = 0; m < 4; ++m) { bf16* rowp = O + (size_t)(row0 + ai * 128 + m * 16) * ldc + col0;
#pragma unroll
                for (int bj = 0; bj < 2; ++bj) { const f32x4 v0 = acc[ai][bj][m][0], v1 = acc[ai][bj][m][1];
                    u32x4 w; w.x = pk2(v0[0], v0[1]); w.y = pk2(v0[2], v0[3]); w.z = pk2(v1[0], v1[1]); w.w = pk2(v1[2], v1[3]);
                    *(u32x4*)(rowp + bj * 128) = w; } }
    }
};
struct EpiQ {
    bf16* Q; const float2* cs16;
    DI void operator()(const f32x4 (&acc)[2][2][4][2], const Unit& u, int wr, int wc, int fr, int fq) const {
        const int row0 = u.om * 256 + wr * 64 + fr;
        if (u.on < 2) {
#pragma unroll
            for (int ai = 0; ai < 2; ++ai)
#pragma unroll
                for (int m = 0; m < 4; ++m) { const int row = row0 + ai * 128 + m * 16;
#pragma unroll
                    for (int bj = 0; bj < 2; ++bj) { const int c = bj * 128 + wc * 32 + 8 * fq; const int hd = 4 * u.on + (c >> 6), d = c & 63;
                        const f32x4 v0 = acc[ai][bj][m][0], v1 = acc[ai][bj][m][1];
                        u32x4 w; w.x = pk2(v0[0], v0[1]); w.y = pk2(v0[2], v0[3]); w.z = pk2(v1[0], v1[1]); w.w = pk2(v1[2], v1[3]);
                        *(u32x4*)(Q + (size_t)row * 768 + hd * 96 + d) = w; } }
        } else {
            const int c = wc * 32 + 8 * fq; const int hd = c >> 4, i0 = c & 15;
#pragma unroll
            for (int ai = 0; ai < 2; ++ai)
#pragma unroll
                for (int m = 0; m < 4; ++m) { const int row = row0 + ai * 128 + m * 16; const int pos = row & (SEQ - 1);
                    const float2* cs = cs16 + pos * 16 + i0;
                    float o1[8], o2[8];
#pragma unroll
                    for (int n = 0; n < 2; ++n)
#pragma unroll
                        for (int j = 0; j < 4; ++j) { const float2 t = cs[n * 4 + j]; const float x1 = acc[ai][0][m][n][j], x2 = acc[ai][1][m][n][j];
                            o1[n * 4 + j] = x1 * t.x - x2 * t.y; o2[n * 4 + j] = x1 * t.y + x2 * t.x; }
                    u32x4 w1, w2; w1.x = pk2(o1[0], o1[1]); w1.y = pk2(o1[2], o1[3]); w1.z = pk2(o1[4], o1[5]); w1.w = pk2(o1[6], o1[7]);
                    w2.x = pk2(o2[0], o2[1]); w2.y = pk2(o2[2], o2[3]); w2.z = pk2(o2[4], o2[5]); w2.w = pk2(o2[6], o2[7]);
                    bf16* qp = Q + (size_t)row * 768 + hd * 96 + 64 + i0;
                    *(u32x4*)(qp) = w1; *(u32x4*)(qp + 16) = w2; }
        }
    }
};
struct EpiResid {
    const float* R; float* O;
    DI void operator()(const f32x4 (&acc)[2][2][4][2], const Unit& u, int wr, int wc, int fr, int fq) const {
        const int row0 = u.om * 256 + wr * 64 + fr, col0 = u.on * 256 + wc * 32 + 8 * fq;
#pragma unroll
        for (int ai = 0; ai < 2; ++ai)
#pragma unroll
            for (int m = 0; m < 4; ++m) { const size_t off = (size_t)(row0 + ai * 128 + m * 16) * DM + col0;
#pragma unroll
                for (int bj = 0; bj < 2; ++bj) { const f32x4 r0 = *(const f32x4*)(R + off + bj * 128), r1 = *(const f32x4*)(R + off + bj * 128 + 4);
                    *(f32x4*)(O + off + bj * 128) = r0 + acc[ai][bj][m][0]; *(f32x4*)(O + off + bj * 128 + 4) = r1 + acc[ai][bj][m][1]; } }
    }
};
DI float silu_f(float x) { return x * __builtin_amdgcn_rcpf(1.0f + __builtin_amdgcn_exp2f(-x * LOG2E)); }
struct EpiSwiglu {
    bf16* O;
    DI void operator()(const f32x4 (&acc)[2][2][4][2], const Unit& u, int wr, int wc, int fr, int fq) const {
        const int row0 = u.om * 256 + wr * 64 + fr, col0 = u.on * 128 + wc * 32 + 8 * fq;
#pragma unroll
        for (int ai = 0; ai < 2; ++ai)
#pragma unroll
            for (int m = 0; m < 4; ++m) { bf16* rowp = O + (size_t)(row0 + ai * 128 + m * 16) * FF + col0;
                float o[8];
#pragma unroll
                for (int n = 0; n < 2; ++n)
#pragma unroll
                    for (int j = 0; j < 4; ++j) o[n * 4 + j] = silu_f(acc[ai][0][m][n][j]) * acc[ai][1][m][n][j];
                u32x4 w; w.x = pk2(o[0], o[1]); w.y = pk2(o[2], o[3]); w.z = pk2(o[4], o[5]); w.w = pk2(o[6], o[7]);
                *(u32x4*)rowp = w; }
    }
};
struct EpiMoeDown {
    float* H; bf16* Y; const unsigned* slot_tok; const float* slot_gate; int slot_base;
    DI void operator()(const f32x4 (&acc)[2][2][4][2], const Unit& u, int wr, int wc, int fr, int fq) const {
        const int row0 = u.om * 256 + wr * 64 + fr, col0 = u.on * 256 + wc * 32 + 8 * fq;
#pragma unroll
        for (int ai = 0; ai < 2; ++ai)
#pragma unroll
            for (int m = 0; m < 4; ++m) { const int slot = slot_base + row0 + ai * 128 + m * 16; const unsigned s = slot_tok[slot];
                if (s) { const unsigned tk = s - 1u; const size_t off = (size_t)(tk >> 1) * DM + col0; const float gt = slot_gate[slot];
                    if ((tk & 1u) == 0u) {
#pragma unroll
                        for (int bj = 0; bj < 2; ++bj) { const f32x4 r0 = *(const f32x4*)(H + off + bj * 128), r1 = *(const f32x4*)(H + off + bj * 128 + 4);
                            *(f32x4*)(H + off + bj * 128) = r0 + acc[ai][bj][m][0] * gt; *(f32x4*)(H + off + bj * 128 + 4) = r1 + acc[ai][bj][m][1] * gt; }
                    } else {
#pragma unroll
                        for (int bj = 0; bj < 2; ++bj) { const f32x4 v0 = acc[ai][bj][m][0] * gt, v1 = acc[ai][bj][m][1] * gt;
                            u32x4 w; w.x = pk2(v0[0], v0[1]); w.y = pk2(v0[2], v0[3]); w.z = pk2(v1[0], v1[1]); w.w = pk2(v1[2], v1[3]);
                            *(u32x4*)(Y + off + bj * 128) = w; }
                    } } }
    }
};

DI void conv_item(const float* W, int N, bf16* WT, int ldk, int dst_row0, int src_col0, int k0, float scale, LAS float* scr, int lane) {
    if (src_col0 >= 0) {
#pragma unroll 8
        for (int i = 0; i < 32; ++i) { const int kk = 2 * i + (lane >> 5); scr[kk * 33 + (lane & 31)] = W[(size_t)(k0 + kk) * N + src_col0 + (lane & 31)] * scale; }
    } else {
#pragma unroll 8
        for (int i = 0; i < 32; ++i) { const int kk = 2 * i + (lane >> 5); scr[kk * 33 + (lane & 31)] = 0.f; }
    }
    asm volatile("s_waitcnt lgkmcnt(0)" ::: "memory");
    const int c = lane & 7;
#pragma unroll
    for (int j = 0; j < 4; ++j) { const int n = (lane >> 3) + 8 * j; const LAS float* s = scr + (8 * c) * 33 + n;
        u32x4 o; o.x = pk2(s[0 * 33], s[1 * 33]); o.y = pk2(s[2 * 33], s[3 * 33]); o.z = pk2(s[4 * 33], s[5 * 33]); o.w = pk2(s[6 * 33], s[7 * 33]);
        *(GAS u32x4*)(WT + (size_t)(dst_row0 + n) * ldk + k0 + 8 * c) = o; }
    asm volatile("s_waitcnt lgkmcnt(0)" ::: "memory");
}
DI int conv_dst(int mode, int src) { return (mode == 0 || mode == 4) ? src : mode == 1 ? (src < 672 ? src : src + 96) : mode == 2 ? ((src >> 7) * 256 + (src & 127)) : ((src >> 7) * 256 + 128 + (src & 127)); }
DI float conv_scale(int mode, int src) { return mode != 4 ? 1.0f : (src < 1024 ? 0.125f * LOG2E : ((src >= 1280 && src < 1792) ? 0.125f : 1.0f)); }
DI void conv_matrix_item(const float* W, int K, int N, bf16* WT, int mode, LAS float* scr, int item, int lane) {
    const int nblk = N / 32, kb = item / nblk, nb = item % nblk, src0 = nb * 32;
    conv_item(W, N, WT, K, conv_dst(mode, src0), src0, kb * 64, conv_scale(mode, src0), scr, lane);
}

DI void rms_row_to_bf16(const float* xrow, const float* g, bf16* orow, int lane) {
    const GAS f32x4* xr = (const GAS f32x4*)xrow + lane; const GAS f32x4* gr = (const GAS f32x4*)g + lane;
    f32x4 v[4]; float s = 0.f;
#pragma unroll
    for (int j = 0; j < 4; ++j) { v[j] = xr[64 * j]; s += (v[j].x * v[j].x + v[j].y * v[j].y) + (v[j].z * v[j].z + v[j].w * v[j].w); }
    const float rs = 1.0f / sqrtf(wave_sum(s) * (1.f / DM) + EPS);
    GAS u32x2* o8 = (GAS u32x2*)orow + lane;
#pragma unroll
    for (int j = 0; j < 4; ++j) { const f32x4 gg = gr[64 * j]; u32x2 o; o.x = pk2(v[j].x * rs * gg.x, v[j].y * rs * gg.y); o.y = pk2(v[j].z * rs * gg.z, v[j].w * rs * gg.w); o8[64 * j] = o; }
}
}
namespace fk {
#define MFMA32(a, b, c) __builtin_amdgcn_mfma_f32_32x32x16_bf16((a), (b), (c), 0, 0, 0)
DI int crow(int i, int h) { return (i & 3) + 8 * (i >> 2) + 4 * h; }
DI int kvpos(int kv) { return (kv & ~12) | ((kv & 4) << 1) | ((kv & 8) >> 1); }
template <int S> DI bf16x8 pack8(const f32x16& x) { u32x4 p; p.x = pk2(x[8 * S], x[8 * S + 1]); p.y = pk2(x[8 * S + 2], x[8 * S + 3]); p.z = pk2(x[8 * S + 4], x[8 * S + 5]); p.w = pk2(x[8 * S + 6], x[8 * S + 7]); return __builtin_bit_cast(bf16x8, p); }
DI f32x16 zero16() { f32x16 z;
#pragma unroll
    for (int i = 0; i < 16; ++i) z[i] = 0.f;
    return z; }
DI float ex2(float x) { return __builtin_amdgcn_exp2f(x); }

template <int NST> DI void qk_tile(const LAS unsigned char* Kb, int kstr, const bf16x8* qf, f32x16& p0, f32x16& p1, int r, int hh) {
    p0 = zero16(); p1 = zero16();
    const LAS unsigned char* k0p = Kb + r * kstr + hh * 16; const LAS unsigned char* k1p = k0p + 32 * kstr;
#pragma unroll
    for (int st = 0; st < NST; ++st) { const bf16x8 a0 = *(const LAS bf16x8*)(k0p + st * 32); const bf16x8 a1 = *(const LAS bf16x8*)(k1p + st * 32);
        p0 = MFMA32(a0, qf[st], p0); p1 = MFMA32(a1, qf[st], p1); }
}
template <int NDB> DI void pv_tile(const LAS unsigned char* Vb, int vstr, int kvoff, const f32x16& p0, const f32x16& p1, f32x16* o, int r, int hh) {
    const LAS unsigned char* vp = Vb + r * vstr + (kvoff + 8 * hh) * 2;
#define FK_PVSTEP(P, A, S) { const bf16x8 pp = pack8<S>(P); _Pragma("unroll") for (int db = 0; db < NDB; ++db) { \
        const bf16x8 vf = *(const LAS bf16x8*)(vp + db * 32 * vstr + (32 * (A) + 16 * (S)) * 2); o[db] = MFMA32(vf, pp, o[db]); } }
    FK_PVSTEP(p0, 0, 0) FK_PVSTEP(p0, 0, 1) FK_PVSTEP(p1, 1, 0) FK_PVSTEP(p1, 1, 1)
#undef FK_PVSTEP
}
template <int NDB> DI void softmax_step(f32x16& p0, f32x16& p1, float& m, float& l, f32x16* o) {
    float mx = p0[0];
#pragma unroll
    for (int i = 1; i < 16; ++i) mx = fmaxf(mx, p0[i]);
#pragma unroll
    for (int i = 0; i < 16; ++i) mx = fmaxf(mx, p1[i]);
    mx = fmaxf(mx, __shfl_xor(mx, 32));
    const float mn = fmaxf(m, mx); const float alpha = ex2(m - mn); float s = 0.f;
#pragma unroll
    for (int i = 0; i < 16; ++i) { p0[i] = ex2(p0[i] - mn); s += p0[i]; }
#pragma unroll
    for (int i = 0; i < 16; ++i) { p1[i] = ex2(p1[i] - mn); s += p1[i]; }
    l = l * alpha + s; m = mn;
#pragma unroll
    for (int db = 0; db < NDB; ++db) o[db] *= alpha;
}
DI void store_o64(bf16* orow, const f32x16* o, float sc, int hh) {
#pragma unroll
    for (int db = 0; db < 2; ++db)
#pragma unroll
        for (int g4 = 0; g4 < 4; ++g4) { u32x2 w; w.x = pk2(o[db][4 * g4] * sc, o[db][4 * g4 + 1] * sc); w.y = pk2(o[db][4 * g4 + 2] * sc, o[db][4 * g4 + 3] * sc);
            *(u32x2*)(orow + 32 * db + 8 * g4 + 4 * hh) = w; }
}
DI void tr_write8(LAS unsigned char* img, int stride, int row0, int pos, const u32x4& v) {
#pragma unroll
    for (int e = 0; e < 8; ++e) *(LAS unsigned short*)(img + (row0 + e) * stride + pos * 2) = (unsigned short)(v[e >> 1] >> (16 * (e & 1)));
}

DI int queue_next(Frame& F, int q) {
    __syncthreads();
    if (threadIdx.x == 0) F.MISC[16] = __hip_atomic_fetch_add(F.ctl + CW_QUEUE + 64 * q, 1u, RLX_AGENT);
    __syncthreads();
    return (int)F.MISC[16];
}

DI void p_post_row(bf16* Prow, int pos, const float* qn, const float* kvn, const float2* cs16, const float2* cs32, int lane) {
    {
        u32x4 v = (u32x4){0u, 0u, 0u, 0u}; if (lane < 48) v = *(const u32x4*)(Prow + PC_QLAT + lane * 8);
        float f[8];
#pragma unroll
        for (int j = 0; j < 4; ++j) { f[2 * j] = bf_lo(v[j]); f[2 * j + 1] = bf_hi(v[j]); }
        float ss = 0.f;
#pragma unroll
        for (int j = 0; j < 8; ++j) ss += f[j] * f[j];
        const float rs = 1.0f / sqrtf(wave_sum(ss) * (1.0f / 384.0f) + EPS);
        if (lane < 48) { const f32x4 g0 = *(const f32x4*)(qn + lane * 8), g1 = *(const f32x4*)(qn + lane * 8 + 4);
            u32x4 w; w.x = pk2(f[0] * rs * g0[0], f[1] * rs * g0[1]); w.y = pk2(f[2] * rs * g0[2], f[3] * rs * g0[3]); w.z = pk2(f[4] * rs * g1[0], f[5] * rs * g1[1]); w.w = pk2(f[6] * rs * g1[2], f[7] * rs * g1[3]);
            *(u32x4*)(Prow + PC_QLAT + lane * 8) = w; }
    }
    {
        u32x4 v = (u32x4){0u, 0u, 0u, 0u}; if (lane < 32) v = *(const u32x4*)(Prow + PC_KVLAT + lane * 8);
        float f[8];
#pragma unroll
        for (int j = 0; j < 4; ++j) { f[2 * j] = bf_lo(v[j]); f[2 * j + 1] = bf_hi(v[j]); }
        float ss = 0.f;
#pragma unroll
        for (int j = 0; j < 8; ++j) ss += f[j] * f[j];
        const float rs = 1.0f / sqrtf(wave_sum(ss) * (1.0f / 256.0f) + EPS);
        if (lane < 32) { const f32x4 g0 = *(const f32x4*)(kvn + lane * 8), g1 = *(const f32x4*)(kvn + lane * 8 + 4);
            u32x4 w; w.x = pk2(f[0] * rs * g0[0], f[1] * rs * g0[1]); w.y = pk2(f[2] * rs * g0[2], f[3] * rs * g0[3]); w.z = pk2(f[4] * rs * g1[0], f[5] * rs * g1[1]); w.w = pk2(f[6] * rs * g1[2], f[7] * rs * g1[3]);
            *(u32x4*)(Prow + PC_KVLAT + lane * 8) = w; }
    }
    if (lane < 16) {
        const float x1 = bf_lo((unsigned)Prow[PC_KROPE + lane]), x2 = bf_lo((unsigned)Prow[PC_KROPE + 16 + lane]); const float2 t = cs16[pos * 16 + lane];
        const unsigned o = pk2(x1 * t.x - x2 * t.y, x1 * t.y + x2 * t.x);
        Prow[PC_KROPE + lane] = (bf16)(o & 0xffffu); Prow[PC_KROPE + 16 + lane] = (bf16)(o >> 16);
    }
    {
        const int hd = lane >> 3, i0 = (lane & 7) * 4; const int ql = pos & 127;
        const float lg2 = log1pf(-ex2(-5.0f - (float)hd)) * LOG2E;
        const float dq = ex2((float)ql * lg2), dk = 0.125f * ex2(-(float)ql * lg2);
        const float2* cs = cs32 + pos * 32 + i0;
#pragma unroll
        for (int which = 0; which < 2; ++which) { bf16* p = Prow + (which ? PC_RK : PC_RQ) + hd * 64 + i0; const float sc = which ? dk : dq;
            const u32x2 a = *(const u32x2*)p, b = *(const u32x2*)(p + 32);
            const float x1[4] = {bf_lo(a.x), bf_hi(a.x), bf_lo(a.y), bf_hi(a.y)}, x2[4] = {bf_lo(b.x), bf_hi(b.x), bf_lo(b.y), bf_hi(b.y)};
            float o1[4], o2[4];
#pragma unroll
            for (int j = 0; j < 4; ++j) { const float2 t = cs[j]; o1[j] = (x1[j] * t.x - x2[j] * t.y) * sc; o2[j] = (x1[j] * t.y + x2[j] * t.x) * sc; }
            u32x2 wa, wb; wa.x = pk2(o1[0], o1[1]); wa.y = pk2(o1[2], o1[3]); wb.x = pk2(o2[0], o2[1]); wb.y = pk2(o2[2], o2[3]);
            *(u32x2*)p = wa; *(u32x2*)(p + 32) = wb; }
    }
}

constexpr int MLA_KSTR = 208, MLA_VSTR = 144, MLA_KBUF = 64 * MLA_KSTR, MLA_VBUF = 64 * MLA_VSTR, MLA_V0 = 2 * MLA_KBUF;
DI void mla_unit(Frame& F, int b, int h, int qb, const bf16* Q, const bf16* KVH, const bf16* P, bf16* MIX) {
    const int tid = threadIdx.x, lane = tid & 63, w = F.wave, r = lane & 31, hh = lane >> 5;
    const int q0 = qb * 256, qw0 = q0 + 32 * w; const size_t tokb = (size_t)b * SEQ;
    bf16x8 qf[6];
    { const bf16* qp = Q + (tokb + qw0 + r) * 768 + h * 96 + 8 * hh;
#pragma unroll
      for (int st = 0; st < 6; ++st) qf[st] = *(const bf16x8*)(qp + 16 * st); }
    const bf16* ksrc = KVH + (tokb + (tid >> 3)) * 1024 + h * 128 + (tid & 7) * 8;
    const bf16* pesrc = P + (tokb + (tid >> 2)) * AB_P + PC_KROPE + (tid & 3) * 8;
    const bf16* vsrc = KVH + (tokb + lane) * 1024 + h * 128 + 64 + w * 8;
    const int kdst = (tid >> 3) * MLA_KSTR + (tid & 7) * 16, pedst = (tid >> 2) * MLA_KSTR + 128 + (tid & 3) * 16, vpos = kvpos(lane);
    const int nt = 4 * (qb + 1);
    u32x4 kreg, pereg = (u32x4){0u, 0u, 0u, 0u}, vreg;
    kreg = *(const u32x4*)ksrc; if (tid < 256) pereg = *(const u32x4*)pesrc; vreg = *(const u32x4*)vsrc;
    float m = -INFINITY, l = 0.f; f32x16 o[2]; o[0] = zero16(); o[1] = zero16();
    for (int t = 0; t < nt; ++t) {
        LAS unsigned char* Kb = F.lds + (t & 1) * MLA_KBUF; LAS unsigned char* Vb = F.lds + MLA_V0 + (t & 1) * MLA_VBUF;
        *(LAS u32x4*)(Kb + kdst) = kreg; if (tid < 256) *(LAS u32x4*)(Kb + pedst) = pereg; tr_write8(Vb, MLA_VSTR, 8 * w, vpos, vreg);
        __syncthreads();
        if (t + 1 < nt) { kreg = *(const u32x4*)(ksrc + (size_t)(t + 1) * 64 * 1024); if (tid < 256) pereg = *(const u32x4*)(pesrc + (size_t)(t + 1) * 64 * AB_P); vreg = *(const u32x4*)(vsrc + (size_t)(t + 1) * 64 * 1024); }
        if (64 * t <= qw0 + 31) {
            f32x16 p0, p1; qk_tile<6>(Kb, MLA_KSTR, qf, p0, p1, r, hh);
            if (64 * t + 63 > qw0) { const int qg = qw0 + r;
#pragma unroll
                for (int i = 0; i < 16; ++i) { const int kv = 64 * t + crow(i, hh); if (kv > qg) p0[i] = -INFINITY; if (kv + 32 > qg) p1[i] = -INFINITY; } }
            softmax_step<2>(p0, p1, m, l, o);
            pv_tile<2>(Vb, MLA_VSTR, 0, p0, p1, o, r, hh);
        }
    }
    l += __shfl_xor(l, 32);
    store_o64(MIX + (tokb + qw0 + r) * 1536 + h * 64, o, 1.0f / l, hh);
}

constexpr int RT_KS = 0, RT_KT = 18432, RT_VT = 35840, RT_ST = 70656, RT_RED = 89088;
DI void ret_unit(Frame& F, int b, int h, const bf16* P, const float* gn, bf16* MIX) {
    const int lane = threadIdx.x & 63, w = F.wave, r = lane & 31, hh = lane >> 5;
    const int qg = w & 3, vh = w >> 2;
    const int dvb = w & 3, db2 = w >> 2;
    const size_t tokb = (size_t)b * SEQ;
    const float lg2 = log1pf(-ex2(-5.0f - (float)h)) * LOG2E;
    const float gam = ex2(lg2), g127 = ex2(127.0f * lg2), g128 = ex2(128.0f * lg2);
    LAS unsigned char* Ks = F.lds + RT_KS; LAS unsigned char* Kt = F.lds + RT_KT; LAS unsigned char* Vt = F.lds + RT_VT; LAS unsigned char* St = F.lds + RT_ST;
    LAS f32x2_t* red = (LAS f32x2_t*)(F.lds + RT_RED);
    f32x16 st = zero16();
    for (int n = 0; n < 16; ++n) {
        const size_t tok0 = tokb + (size_t)n * 128;
        __syncthreads();
#pragma unroll
        for (int i = 0; i < 16; ++i) *(LAS unsigned short*)(St + (32 * dvb + crow(i, hh)) * 144 + (32 * db2 + r) * 2) = (unsigned short)(pk2(st[i] * gam, 0.f) & 0xffffu);
#pragma unroll
        for (int it = 0; it < 2; ++it) { const int row = lane + 64 * it; const bf16* prow = P + (tok0 + row) * AB_P;
            const u32x4 kreg = *(const u32x4*)(prow + PC_RK + h * 64 + w * 8);
            *(LAS u32x4*)(Ks + row * 144 + w * 16) = kreg; tr_write8(Kt, 272, 8 * w, kvpos(row), kreg);
            const u32x4 v0 = *(const u32x4*)(prow + PC_RV + h * 128 + w * 8), v1 = *(const u32x4*)(prow + PC_RV + h * 128 + (w + 8) * 8);
            tr_write8(Vt, 272, 8 * w, kvpos(row), v0); tr_write8(Vt, 272, 8 * (w + 8), kvpos(row), v1); }
        bf16x8 qf[4];
        { const bf16* qp = P + (tok0 + 32 * qg + r) * AB_P + PC_RQ + h * 64 + 8 * hh;
#pragma unroll
          for (int s4 = 0; s4 < 4; ++s4) qf[s4] = *(const bf16x8*)(qp + 16 * s4); }
        __syncthreads();
        f32x16 o[2]; o[0] = zero16(); o[1] = zero16();
        const int ntile = (qg >> 1) + 1;
        for (int kt = 0; kt < ntile; ++kt) {
            f32x16 p0, p1; qk_tile<4>(Ks + kt * 64 * 144, 144, qf, p0, p1, r, hh);
            if (kt == (qg >> 1)) { const int ql = 32 * qg + r;
#pragma unroll
                for (int i = 0; i < 16; ++i) { const int kv = 64 * kt + crow(i, hh); if (kv > ql) p0[i] = 0.f; if (kv + 32 > ql) p1[i] = 0.f; } }
            pv_tile<2>(Vt + 64 * vh * 272, 272, 64 * kt, p0, p1, o, r, hh);
        }
#pragma unroll
        for (int s4 = 0; s4 < 4; ++s4)
#pragma unroll
            for (int db = 0; db < 2; ++db) { const bf16x8 sf = *(const LAS bf16x8*)(St + (64 * vh + 32 * db + r) * 144 + (16 * s4 + 8 * hh) * 2); o[db] = MFMA32(sf, qf[s4], o[db]); }
        float s1 = 0.f, s2 = 0.f;
#pragma unroll
        for (int db = 0; db < 2; ++db)
#pragma unroll
            for (int i = 0; i < 16; ++i) { s1 += o[db][i]; s2 += o[db][i] * o[db][i]; }
        s1 += __shfl_xor(s1, 32); s2 += __shfl_xor(s2, 32);
        if (hh == 0) red[(32 * qg + r) * 2 + vh] = (f32x2_t){s1, s2};
        {
            f32x16 acc = zero16();
#pragma unroll
            for (int s8 = 0; s8 < 8; ++s8) { const bf16x8 vf = *(const LAS bf16x8*)(Vt + (32 * dvb + r) * 272 + (16 * s8 + 8 * hh) * 2); const bf16x8 kf = *(const LAS bf16x8*)(Kt + (32 * db2 + r) * 272 + (16 * s8 + 8 * hh) * 2);
                acc = MFMA32(vf, kf, acc); }
            st = st * g128 + acc * g127;
        }
        __syncthreads();
        const f32x2_t ra = red[(32 * qg + r) * 2], rb = red[(32 * qg + r) * 2 + 1];
        const float mu = (ra.x + rb.x) * (1.0f / 128.0f); const float var = (ra.y + rb.y) * (1.0f / 128.0f) - mu * mu; const float rs = 1.0f / sqrtf(var + EPS);
        const size_t tok = tok0 + 32 * qg + r; const bf16* rgp = P + tok * AB_P + PC_RG + h * 128 + 64 * vh; const float* gnp = gn + h * 128 + 64 * vh; bf16* op = MIX + tok * 1536 + 512 + h * 128 + 64 * vh;
#pragma unroll
        for (int db = 0; db < 2; ++db)
#pragma unroll
            for (int g4 = 0; g4 < 4; ++g4) { const int dv = 32 * db + 8 * g4 + 4 * hh; const u32x2 gv = *(const u32x2*)(rgp + dv); const f32x4 gg = *(const f32x4*)(gnp + dv);
                const float g0 = bf_lo(gv.x), g1 = bf_hi(gv.x), g2 = bf_lo(gv.y), g3 = bf_hi(gv.y);
                u32x2 wv; wv.x = pk2(silu_f(g0) * ((o[db][4 * g4] - mu) * rs * gg[0]), silu_f(g1) * ((o[db][4 * g4 + 1] - mu) * rs * gg[1]));
                wv.y = pk2(silu_f(g2) * ((o[db][4 * g4 + 2] - mu) * rs * gg[2]), silu_f(g3) * ((o[db][4 * g4 + 3] - mu) * rs * gg[3]));
                *(u32x2*)(op + dv) = wv; }
    }
}

constexpr int SW_KS = 0, SW_VT = 36864, SW_VSTR = 528;
DI void swa_unit(Frame& F, int b, int hkv, int blk, const bf16* P2, const float* sinks, bf16* MIX2) {
    const int tid = threadIdx.x, lane = tid & 63, w = F.wave, r = lane & 31, hh = lane >> 5; const size_t tokb = (size_t)b * SEQ;
    const int kb0 = 128 * (blk - 1);
    LAS unsigned char* Ks = F.lds + SW_KS; LAS unsigned char* Vt = F.lds + SW_VT;
#pragma unroll
    for (int it = 0; it < 4; ++it) { const int c = tid + 512 * it, row = c >> 3, part = c & 7; const int key = kb0 + row;
        u32x4 v = (u32x4){0u, 0u, 0u, 0u}; if (key >= 0) v = *(const u32x4*)(P2 + (tokb + key) * CD_IN + P2_SK + hkv * 64 + part * 8);
        *(LAS u32x4*)(Ks + row * 144 + part * 16) = v; }
#pragma unroll
    for (int it = 0; it < 4; ++it) { const int row = lane + 64 * it; const int key = kb0 + row;
        u32x4 v = (u32x4){0u, 0u, 0u, 0u}; if (key >= 0) v = *(const u32x4*)(P2 + (tokb + key) * CD_IN + P2_SV + hkv * 64 + w * 8);
        tr_write8(Vt, SW_VSTR, 8 * w, kvpos(row), v); }
    __syncthreads();
    const int hq = hkv * 8 + w; const float slope2 = ex2(-8.0f * (float)(hq + 1) / 16.0f) * LOG2E, sink2 = sinks[hq] * LOG2E;
    for (int j = 0; j < 4; ++j) {
        const int qrow = 128 * blk + 32 * j + r; const int qband = 128 + 32 * j + r;
        bf16x8 qf[4];
        { const bf16* qp = P2 + (tokb + qrow) * CD_IN + P2_SQ + hq * 64 + 8 * hh;
#pragma unroll
          for (int s4 = 0; s4 < 4; ++s4) qf[s4] = *(const bf16x8*)(qp + 16 * s4); }
        float m = sink2, l = (hh == 0) ? 1.0f : 0.0f; f32x16 o[2]; o[0] = zero16(); o[1] = zero16();
        const int bt_lo = (32 * j + 1) >> 6, bt_hi = (32 * j + 159) >> 6;
        for (int bt = bt_lo; bt <= bt_hi; ++bt) {
            f32x16 p0, p1; qk_tile<4>(Ks + bt * 64 * 144, 144, qf, p0, p1, r, hh);
#pragma unroll
            for (int i = 0; i < 16; ++i) { const int k0 = 64 * bt + crow(i, hh), k1 = k0 + 32; const int d0 = qband - k0, d1 = qband - k1;
                p0[i] = (d0 >= 0 && d0 < 128 && kb0 + k0 >= 0) ? p0[i] - slope2 * (float)d0 : -INFINITY;
                p1[i] = (d1 >= 0 && d1 < 128 && kb0 + k1 >= 0) ? p1[i] - slope2 * (float)d1 : -INFINITY; }
            softmax_step<2>(p0, p1, m, l, o);
            pv_tile<2>(Vt, SW_VSTR, 64 * bt, p0, p1, o, r, hh);
        }
        l += __shfl_xor(l, 32);
        store_o64(MIX2 + (tokb + qrow) * 1536 + hq * 64, o, 1.0f / l, hh);
    }
}

constexpr int SB_K0 = 0, SB_V0 = 18432, SB_FLAG = 36864, SB_BUF = 9216;
constexpr float SB_EXIT = 110.0f;
DI float softplus_f(float z) { return fmaxf(z, 0.f) + 0.6931471805599453f * __builtin_amdgcn_logf(1.0f + ex2(-fabsf(z) * LOG2E)); }
DI void sb_unit(Frame& F, int b, int h, int qb, const bf16* P2, bf16* MIX2) {
    const int tid = threadIdx.x, lane = tid & 63, w = F.wave, r = lane & 31, hh = lane >> 5; const size_t tokb = (size_t)b * SEQ;
    const int q0 = qb * 256, qw0 = q0 + 32 * w, qg = qw0 + r;
    bf16x8 qf[4];
    { const bf16* qp = P2 + (tokb + qg) * CD_IN + P2_BQ + h * 64 + 8 * hh;
#pragma unroll
      for (int s4 = 0; s4 < 4; ++s4) qf[s4] = *(const bf16x8*)(qp + 16 * s4); }
    const bf16* ksrc = P2 + (tokb + (tid >> 3)) * CD_IN + P2_BK + h * 64 + (tid & 7) * 8;
    const bf16* vsrc = P2 + (tokb + lane) * CD_IN + P2_BV + h * 64 + w * 8;
    const int kdst = (tid >> 3) * 144 + (tid & 7) * 16, vpos = kvpos(lane);
    LAS unsigned* flags = (LAS unsigned*)(F.lds + SB_FLAG);
    const int tmax = 4 * qb + 3;
    u32x4 kreg = *(const u32x4*)(ksrc + (size_t)tmax * 64 * CD_IN), vreg = *(const u32x4*)(vsrc + (size_t)tmax * 64 * CD_IN);
    float run = 0.f; bool wdone = false; f32x16 o[2]; o[0] = zero16(); o[1] = zero16();
    int it = 0;
    for (int t = tmax; t >= 0; --t, ++it) {
        LAS unsigned char* Kb = F.lds + SB_K0 + (it & 1) * SB_BUF; LAS unsigned char* Vb = F.lds + SB_V0 + (it & 1) * SB_BUF;
        *(LAS u32x4*)(Kb + kdst) = kreg; tr_write8(Vb, 144, 8 * w, vpos, vreg);
        if (lane == 0) flags[(it & 1) * 8 + w] = wdone ? 1u : 0u;
        __syncthreads();
        unsigned alld = 1u;
#pragma unroll
        for (int x = 0; x < 8; ++x) alld &= flags[(it & 1) * 8 + x];
        if (alld) break;
        if (t > 0) { kreg = *(const u32x4*)(ksrc + (size_t)(t - 1) * 64 * CD_IN); vreg = *(const u32x4*)(vsrc + (size_t)(t - 1) * 64 * CD_IN); }
        if (64 * t <= qw0 + 30 && !wdone) {
            f32x16 z0, z1; qk_tile<4>(Kb, 144, qf, z0, z1, r, hh);
            f32x16 s0, s1v; float gs[8];
#pragma unroll
            for (int i = 0; i < 16; ++i) { const int kv = 64 * t + crow(i, hh); s0[i] = (kv < qg) ? softplus_f(z0[i]) : 0.f; s1v[i] = (kv + 32 < qg) ? softplus_f(z1[i]) : 0.f; }
#pragma unroll
            for (int g4 = 0; g4 < 4; ++g4) { gs[g4] = (s0[4 * g4] + s0[4 * g4 + 1]) + (s0[4 * g4 + 2] + s0[4 * g4 + 3]); gs[4 + g4] = (s1v[4 * g4] + s1v[4 * g4 + 1]) + (s1v[4 * g4 + 2] + s1v[4 * g4 + 3]); }
            float above[8]; float accs = 0.f;
#pragma unroll
            for (int gi = 7; gi >= 0; --gi) { const float oth = __shfl_xor(gs[gi], 32); above[gi] = accs + (hh == 0 ? oth : 0.f); accs += gs[gi] + oth; }
#pragma unroll
            for (int g4 = 0; g4 < 4; ++g4) {
                { float c = run + above[g4];
#pragma unroll
                  for (int e = 3; e >= 0; --e) { const int i = 4 * g4 + e; c += s0[i]; const int kv = 64 * t + crow(i, hh); z0[i] = (kv < qg) ? ex2((z0[i] - c) * LOG2E) : 0.f; } }
                { float c = run + above[4 + g4];
#pragma unroll
                  for (int e = 3; e >= 0; --e) { const int i = 4 * g4 + e; c += s1v[i]; const int kv = 64 * t + 32 + crow(i, hh); z1[i] = (kv < qg) ? ex2((z1[i] - c) * LOG2E) : 0.f; } }
            }
            pv_tile<2>(Vb, 144, 0, z0, z1, o, r, hh);
            run += accs;
            wdone = __all(run > SB_EXIT);
        }
    }
    store_o64(MIX2 + (tokb + qg) * 1536 + 1024 + h * 64, o, 1.0f, hh);
}
}
namespace fk {
enum InIdx { I_X = 0, I_AB_NORM, I_AB_W_IN, I_Q_NORM, I_W_UQ, I_KV_NORM, I_W_UKV, I_RET_GN, I_AB_W_OUT, I_FFN_NORM, I_FFN_WG, I_FFN_WU, I_FFN_WD,
             I_CD_NORM, I_CD_W_IN, I_SINKS, I_CD_W_OUT, I_MOE_NORM, I_ROUTER, I_MOE_WG, I_MOE_WU, I_MOE_WD, I_FINAL_NORM };

DI void prologue_phase(Frame& F, const Args& A) {
    const int tid = threadIdx.x, lane = tid & 63;
    const int gt = F.bid * NTHR + tid, NGT = F.G * NTHR;
    float2* cs16 = (float2*)(F.ws + WS_CS16); float2* cs32 = (float2*)(F.ws + WS_CS32);
    for (int e = gt; e < SEQ * 48; e += NGT) {
        float sn, cs;
        if (e < SEQ * 16) { const int pos = e >> 4, i = e & 15; rope_cs(pos, i, 16, sn, cs); cs16[e] = make_float2(cs, sn); }
        else { const int e2 = e - SEQ * 16; const int pos = e2 >> 5, i = e2 & 31; rope_cs(pos, i, 32, sn, cs); cs32[e2] = make_float2(cs, sn); }
    }
    {
        const float* W = A.in[I_W_UQ]; bf16* WT = (bf16*)(F.ws + WS_W_UQ); const float sc = 0.10206207261596575f * LOG2E;
        for (int e = gt; e < 768 * 384; e += NGT) { const int n = e / 384, k = e - n * 384; int src;
            if (n < 512) src = (n >> 6) * 96 + (n & 63); else if (n < 640) { const int c = n - 512; src = (c >> 4) * 96 + 64 + (c & 15); } else { const int c = n - 640; src = (c >> 4) * 96 + 80 + (c & 15); }
            WT[e] = (bf16)(pk2(W[(size_t)k * 768 + src] * sc, 0.f) & 0xffffu); }
    }
    LAS float* scr = (LAS float*)(F.lds + F.wave * 16384);
    const int gw = F.bid * NWAVES + F.wave, NGW = F.G * NWAVES;
    constexpr int N_ABIN = 16 * 117, N_ABPAD = 16 * 3, N_UKV = 4 * 32, N_ABOUT = 24 * 32, N_FG = 16 * 112, N_FD = 56 * 32, N_CDIN = 16 * 88, N_CDOUT = 24 * 32;
    constexpr int NITEMS = N_ABIN + N_ABPAD + N_UKV + N_ABOUT + 2 * N_FG + N_FD + N_CDIN + N_CDOUT;
    for (int it = gw; it < NITEMS; it += NGW) {
        int q = it;
        if (q < N_ABIN) { conv_matrix_item(A.in[I_AB_W_IN], 1024, AB_IN, (bf16*)(F.ws + WS_W_ABIN), 1, scr, q, lane); continue; } q -= N_ABIN;
        if (q < N_ABPAD) { conv_item(A.in[I_AB_W_IN], AB_IN, (bf16*)(F.ws + WS_W_ABIN), 1024, 672 + 32 * (q % 3), -1, 64 * (q / 3), 1.f, scr, lane); continue; } q -= N_ABPAD;
        if (q < N_UKV) { conv_matrix_item(A.in[I_W_UKV], 256, 1024, (bf16*)(F.ws + WS_W_UKV), 0, scr, q, lane); continue; } q -= N_UKV;
        if (q < N_ABOUT) { conv_matrix_item(A.in[I_AB_W_OUT], 1536, 1024, (bf16*)(F.ws + WS_W_ABOUT), 0, scr, q, lane); continue; } q -= N_ABOUT;
        if (q < N_FG) { conv_matrix_item(A.in[I_FFN_WG], 1024, FF, (bf16*)(F.ws + WS_W_FGU), 2, scr, q, lane); continue; } q -= N_FG;
        if (q < N_FG) { conv_matrix_item(A.in[I_FFN_WU], 1024, FF, (bf16*)(F.ws + WS_W_FGU), 3, scr, q, lane); continue; } q -= N_FG;
        if (q < N_FD) { conv_matrix_item(A.in[I_FFN_WD], FF, 1024, (bf16*)(F.ws + WS_W_FD), 0, scr, q, lane); continue; } q -= N_FD;
        if (q < N_CDIN) { conv_matrix_item(A.in[I_CD_W_IN], 1024, CD_IN, (bf16*)(F.ws + WS_W_CDIN), 4, scr, q, lane); continue; } q -= N_CDIN;
        conv_matrix_item(A.in[I_CD_W_OUT], 1536, 1024, (bf16*)(F.ws + WS_W_CDOUT), 0, scr, q, lane);
    }
    for (int m = gw; m < T; m += NGW) rms_row_to_bf16(A.in[I_X] + (size_t)m * DM, A.in[I_AB_NORM], (bf16*)(F.ws + WS_XN) + (size_t)m * DM, lane);
}
DI void moe_conv_phase(Frame& F, const Args& A) {
    const int lane = threadIdx.x & 63;
    LAS float* scr = (LAS float*)(F.lds + F.wave * 16384);
    const int gw = F.bid * NWAVES + F.wave, NGW = F.G * NWAVES;
    constexpr int N_G = 16 * 112, N_D = 56 * 32, PER = 2 * N_G + N_D;
    for (int it = gw; it < NEXP * PER; it += NGW) { const int e = it / PER; int q = it - e * PER;
        if (q < N_G) { conv_matrix_item(A.in[I_MOE_WG] + (size_t)e * 1024 * FF, 1024, FF, (bf16*)(F.ws + WS_MOEW_GU) + (size_t)e * 7168 * 1024, 2, scr, q, lane); continue; } q -= N_G;
        if (q < N_G) { conv_matrix_item(A.in[I_MOE_WU] + (size_t)e * 1024 * FF, 1024, FF, (bf16*)(F.ws + WS_MOEW_GU) + (size_t)e * 7168 * 1024, 3, scr, q, lane); continue; } q -= N_G;
        conv_matrix_item(A.in[I_MOE_WD] + (size_t)e * FF * 1024, FF, 1024, (bf16*)(F.ws + WS_MOEW_D) + (size_t)e * 1024 * FF, 0, scr, q, lane);
    }
}
DI void norm_phase(Frame& F, const float* g, bf16* XN) {
    const int lane = threadIdx.x & 63;
    const int gw = F.bid * NWAVES + F.wave, NGW = F.G * NWAVES;
    for (int m = gw; m < T; m += NGW) rms_row_to_bf16(F.out + (size_t)m * DM, g, XN + (size_t)m * DM, lane);
}
DI void ppost_phase(Frame& F, const Args& A) {
    const int lane = threadIdx.x & 63;
    const int gw = F.bid * NWAVES + F.wave, NGW = F.G * NWAVES; bf16* P = (bf16*)(F.ws + WS_P);
    for (int m = gw; m < T; m += NGW) p_post_row(P + (size_t)m * AB_P, m & (SEQ - 1), A.in[I_Q_NORM], A.in[I_KV_NORM], (const float2*)(F.ws + WS_CS16), (const float2*)(F.ws + WS_CS32), lane);
}
constexpr int RL_TE = 32768, RL_TG = 33792, RL_RANK = 34816, RL_CNT = 35840, RL_BASE = 35872;
DI void route_phase_a(Frame& F, const Args& A) {
    const int tid = threadIdx.x, lane = tid & 63;
    LAS float* rt = (LAS float*)F.lds; LAS int* te = (LAS int*)(F.lds + RL_TE); LAS float* tg = (LAS float*)(F.lds + RL_TG); LAS int* trank = (LAS int*)(F.lds + RL_RANK);
    LAS unsigned* lcnt = (LAS unsigned*)(F.lds + RL_CNT); LAS unsigned* lbase = (LAS unsigned*)(F.lds + RL_BASE);
    for (int i = tid; i < 8192; i += NTHR) rt[i] = A.in[I_ROUTER][i];
    if (tid < 8) lcnt[tid] = 0u;
    __syncthreads();
    const float* g = A.in[I_MOE_NORM]; bf16* XN3 = (bf16*)(F.ws + WS_XN3);
    for (int q = 0; q < 16; ++q) {
        const int tl = F.wave * 16 + q; const size_t tok = (size_t)F.bid * 128 + tl;
        const GAS f32x4* xr = (const GAS f32x4*)(F.out + tok * DM) + lane; const GAS f32x4* gr = (const GAS f32x4*)g + lane;
        f32x4 v[4]; float s = 0.f;
#pragma unroll
        for (int j = 0; j < 4; ++j) { v[j] = xr[64 * j]; s += (v[j].x * v[j].x + v[j].y * v[j].y) + (v[j].z * v[j].z + v[j].w * v[j].w); }
        const float rs = 1.0f / sqrtf(wave_sum(s) * (1.f / DM) + EPS);
        float lg[8];
#pragma unroll
        for (int e = 0; e < 8; ++e) lg[e] = 0.f;
        GAS u32x2* o8 = (GAS u32x2*)(XN3 + tok * DM) + lane;
#pragma unroll
        for (int j = 0; j < 4; ++j) { const f32x4 gg = gr[64 * j]; const f32x4 xn = (f32x4){v[j].x * rs * gg.x, v[j].y * rs * gg.y, v[j].z * rs * gg.z, v[j].w * rs * gg.w};
            u32x2 o; o.x = pk2(xn.x, xn.y); o.y = pk2(xn.z, xn.w); o8[64 * j] = o;
            const int k0 = (64 * j + lane) * 4;
#pragma unroll
            for (int c = 0; c < 4; ++c) { const f32x4 r0 = *(const LAS f32x4*)(rt + (k0 + c) * 8), r1 = *(const LAS f32x4*)(rt + (k0 + c) * 8 + 4); const float xv = xn[c];
                lg[0] += xv * r0[0]; lg[1] += xv * r0[1]; lg[2] += xv * r0[2]; lg[3] += xv * r0[3]; lg[4] += xv * r1[0]; lg[5] += xv * r1[1]; lg[6] += xv * r1[2]; lg[7] += xv * r1[3]; } }
#pragma unroll
        for (int e = 0; e < 8; ++e) lg[e] = wave_sum(lg[e]);
        if (lane == 0) {
            int e0 = 0; float b0 = lg[0];
#pragma unroll
            for (int e = 1; e < 8; ++e) if (lg[e] > b0) { b0 = lg[e]; e0 = e; }
            int e1 = 0; float b1 = -INFINITY;
#pragma unroll
            for (int e = 0; e < 8; ++e) if (e != e0 && lg[e] > b1) { b1 = lg[e]; e1 = e; }
            const float p1 = __expf(b1 - b0); const float g0 = 1.0f / (1.0f + p1), g1 = p1 / (1.0f + p1);
            te[tl * 2] = e0; te[tl * 2 + 1] = e1; tg[tl * 2] = g0; tg[tl * 2 + 1] = g1;
            trank[tl * 2] = (int)__hip_atomic_fetch_add(lcnt + e0, 1u, __ATOMIC_RELAXED, __HIP_MEMORY_SCOPE_WORKGROUP);
            trank[tl * 2 + 1] = (int)__hip_atomic_fetch_add(lcnt + e1, 1u, __ATOMIC_RELAXED, __HIP_MEMORY_SCOPE_WORKGROUP);
        }
    }
    __syncthreads();
    if (tid < 8) lbase[tid] = __hip_atomic_fetch_add(F.ctl + CW_ECNT + 64 * tid, lcnt[tid], RLX_AGENT);
}
struct MoeGeom { int pend[8]; int npanels; };
DI MoeGeom moe_geom(Frame& F) {
    MoeGeom mg; int acc = 0;
#pragma unroll
    for (int e = 0; e < 8; ++e) { const unsigned c = __hip_atomic_load(F.ctl + CW_ECNT + 64 * e, RLX_AGENT); acc += (int)((c + 255u) >> 8); mg.pend[e] = acc; }
    mg.npanels = acc; return mg;
}
DI void route_phase_b(Frame& F, const MoeGeom& mg) {
    const int tid = threadIdx.x;
    LAS int* te = (LAS int*)(F.lds + RL_TE); LAS float* tg = (LAS float*)(F.lds + RL_TG); LAS int* trank = (LAS int*)(F.lds + RL_RANK); LAS unsigned* lbase = (LAS unsigned*)(F.lds + RL_BASE);
    gu32* slot_tok = F.ctl + CW_SLOT_TOK; GAS float* slot_gate = (GAS float*)(F.ctl + CW_SLOT_GATE);
    for (int idx = tid; idx < 256; idx += NTHR) { const int e = te[idx]; int pstart = 0;
#pragma unroll
        for (int x = 0; x < 7; ++x) if (e > x) pstart = mg.pend[x];
        const int slot = pstart * 256 + (int)lbase[e] + trank[idx];
        const unsigned tk = (unsigned)(F.bid * 128 + (idx >> 1)) * 2u + (unsigned)(idx & 1);
        slot_tok[slot] = tk + 1u; slot_gate[slot] = tg[idx]; }
}
struct MoeOrder {
    int cp0, cpn, ntile, tiles_per_exp, G, c; bool gather; int pend[8];
    DI bool next(int i, Unit& u) const {
        const long L = (long)i * G + c; if (L >= (long)cpn * ntile) return false;
        const int pl = (int)(L % cpn), pn = (int)(L / cpn), panel = cp0 + pl; int e = 0;
#pragma unroll
        for (int x = 0; x < 7; ++x) if (panel >= pend[x]) e = x + 1;
        u.pm = gather ? panel : pl; u.pn = e * tiles_per_exp + pn; u.om = pl; u.on = pn; u.ex = e; return true;
    }
};
DI void final_phase(Frame& F, const Args& A) {
    const int lane = threadIdx.x & 63;
    const int gw = F.bid * NWAVES + F.wave, NGW = F.G * NWAVES; const float* g = A.in[I_FINAL_NORM]; const bf16* Y = (const bf16*)(F.ws + WS_YBUF);
    for (int m = gw; m < T; m += NGW) {
        GAS f32x4* xr = (GAS f32x4*)(F.out + (size_t)m * DM) + lane; const GAS u32x2* yr = (const GAS u32x2*)(Y + (size_t)m * DM) + lane; const GAS f32x4* gr = (const GAS f32x4*)g + lane;
        f32x4 v[4]; float s = 0.f;
#pragma unroll
        for (int j = 0; j < 4; ++j) { v[j] = xr[64 * j]; const u32x2 y = yr[64 * j]; v[j].x += bf_lo(y.x); v[j].y += bf_hi(y.x); v[j].z += bf_lo(y.y); v[j].w += bf_hi(y.y);
            s += (v[j].x * v[j].x + v[j].y * v[j].y) + (v[j].z * v[j].z + v[j].w * v[j].w); }
        const float rs = 1.0f / sqrtf(wave_sum(s) * (1.f / DM) + EPS);
#pragma unroll
        for (int j = 0; j < 4; ++j) { const f32x4 gg = gr[64 * j]; xr[64 * j] = (f32x4){v[j].x * rs * gg.x, v[j].y * rs * gg.y, v[j].z * rs * gg.z, v[j].w * rs * gg.w}; }
    }
}

constexpr int N_PHASES = 16;
__global__ void __launch_bounds__(NTHR, 2) mega_fwd(Args args) {
    extern __shared__ __attribute__((aligned(16))) unsigned char lds_raw[];
    Frame F;
    F.lds = (LAS unsigned char*)lds_raw; F.MISC = (volatile LAS unsigned*)(F.lds + MISC_OFF);
    F.wave = __builtin_amdgcn_readfirstlane((int)threadIdx.x >> 6); F.G = gridDim.x; F.bid = blockIdx.x;
    F.ws = args.ws; F.ctl = (gu32*)(args.ws + WS_CTL); F.out = args.out;
    const Args& A = args;
    if (threadIdx.x < 32) F.MISC[threadIdx.x] = 0u;
    __syncthreads();
    XcdBarrier bar = xcd_barrier_post((unsigned*)(F.ctl + CW_BAR) + args.li * XCD_BAR_WORDS, F.MISC + 8);
    const int lo = args.ph_lo, hi = args.ph_hi;
#define IN(k) (lo <= (k) && (k) < hi)
#define SEAM(k) do { if (IN(k) && IN((k) + 1)) xcd_barrier(bar); } while (0)
    unsigned char* ws = F.ws;
    bf16* XN = (bf16*)(ws + WS_XN); bf16* P = (bf16*)(ws + WS_P); bf16* Qb = (bf16*)(ws + WS_Q); bf16* KVH = (bf16*)(ws + WS_KVH); bf16* MIX = (bf16*)(ws + WS_MIXED);
    bf16* HACT = (bf16*)(ws + WS_HACT); bf16* P2 = (bf16*)(ws + WS_P2); bf16* MIX2 = (bf16*)(ws + WS_MIXED2); bf16* MACT = (bf16*)(ws + WS_MACT); bf16* XN3 = (bf16*)(ws + WS_XN3); bf16* YB = (bf16*)(ws + WS_YBUF);

    if (IN(0)) prologue_phase(F, A);
    SEAM(0);
    if (IN(1)) { Gemm g{XN, (const bf16*)(ws + WS_W_ABIN), 1024, 1024, 1024, nullptr}; pg8::StaticOrder S; S.init(T, AB_P, F.G, F.bid); EpiBf16 E{P, AB_P};
        pg8::gemm_phase<EpiBf16, pg8::StaticOrder, false>(F.lds, g, S, E); }
    SEAM(1);
    if (IN(2)) ppost_phase(F, A);
    SEAM(2);
    if (IN(3)) {
        { Gemm g{P + PC_QLAT, (const bf16*)(ws + WS_W_UQ), AB_P, 384, 384, nullptr}; pg8::StaticOrder S; S.init(T, 768, F.G, F.bid); EpiQ E{Qb, (const float2*)(ws + WS_CS16)};
          pg8::gemm_phase<EpiQ, pg8::StaticOrder, false>(F.lds, g, S, E); }
        { Gemm g{P + PC_KVLAT, (const bf16*)(ws + WS_W_UKV), AB_P, 256, 256, nullptr}; pg8::StaticOrder S; S.init(T, 1024, F.G, F.bid); EpiBf16 E{KVH, 1024};
          pg8::gemm_phase<EpiBf16, pg8::StaticOrder, false>(F.lds, g, S, E); }
    }
    SEAM(3);
    if (IN(4)) {
        for (;;) { const int it = queue_next(F, 0); if (it >= 128 + 1024) break;
            if (it < 128) ret_unit(F, it >> 3, it & 7, P, A.in[I_RET_GN], MIX);
            else { const int j = it - 128; const int qb = 7 - (j >> 7), bh = j & 127; mla_unit(F, bh >> 3, bh & 7, qb, Qb, KVH, P, MIX); } }
    }
    SEAM(4);
    if (IN(5)) { Gemm g{MIX, (const bf16*)(ws + WS_W_ABOUT), 1536, 1536, 1536, nullptr}; pg8::StaticOrder S; S.init(T, 1024, F.G, F.bid); EpiResid E{A.in[I_X], F.out};
        pg8::gemm_phase<EpiResid, pg8::StaticOrder, false>(F.lds, g, S, E); }
    SEAM(5);
    if (IN(6)) { norm_phase(F, A.in[I_FFN_NORM], XN); moe_conv_phase(F, A); }
    SEAM(6);
    if (IN(7)) { Gemm g{XN, (const bf16*)(ws + WS_W_FGU), 1024, 1024, 1024, nullptr}; pg8::StaticOrder S; S.init(T, 7168, F.G, F.bid); EpiSwiglu E{HACT};
        pg8::gemm_phase<EpiSwiglu, pg8::StaticOrder, false>(F.lds, g, S, E); }
    SEAM(7);
    if (IN(8)) { Gemm g{HACT, (const bf16*)(ws + WS_W_FD), FF, FF, FF, nullptr}; pg8::StaticOrder S; S.init(T, 1024, F.G, F.bid); EpiResid E{F.out, F.out};
        pg8::gemm_phase<EpiResid, pg8::StaticOrder, false>(F.lds, g, S, E); }
    SEAM(8);
    if (IN(9)) norm_phase(F, A.in[I_CD_NORM], XN);
    SEAM(9);
    if (IN(10)) { Gemm g{XN, (const bf16*)(ws + WS_W_CDIN), 1024, 1024, 1024, nullptr}; pg8::StaticOrder S; S.init(T, CD_IN, F.G, F.bid); EpiBf16 E{P2, CD_IN};
        pg8::gemm_phase<EpiBf16, pg8::StaticOrder, false>(F.lds, g, S, E); }
    SEAM(10);
    if (IN(11)) {
        for (;;) { const int it = queue_next(F, 1); if (it >= 1024 + 512) break;
            if (it < 1024) { const int qb = 7 - (it >> 7), bh = it & 127; sb_unit(F, bh >> 3, bh & 7, qb, P2, MIX2); }
            else { const int j = it - 1024; swa_unit(F, j >> 5, (j >> 4) & 1, j & 15, P2, A.in[I_SINKS], MIX2); } }
    }
    SEAM(11);
    if (IN(12)) { Gemm g{MIX2, (const bf16*)(ws + WS_W_CDOUT), 1536, 1536, 1536, nullptr}; pg8::StaticOrder S; S.init(T, 1024, F.G, F.bid); EpiResid E{F.out, F.out};
        pg8::gemm_phase<EpiResid, pg8::StaticOrder, false>(F.lds, g, S, E); }
    SEAM(12);
    if (IN(13)) { route_phase_a(F, A); xcd_barrier(bar); const MoeGeom mg = moe_geom(F); route_phase_b(F, mg); }
    SEAM(13);
    if (IN(14)) {
        const MoeGeom mg = moe_geom(F); const int nchunk = (mg.npanels + CHUNK_PANELS - 1) / CHUNK_PANELS;
        const unsigned* slot_tok = (const unsigned*)(F.ctl + CW_SLOT_TOK); const float* slot_gate = (const float*)(F.ctl + CW_SLOT_GATE);
        for (int c = 0; c < nchunk; ++c) {
            const int cp0 = c * CHUNK_PANELS, cpn = (mg.npanels - cp0) < CHUNK_PANELS ? (mg.npanels - cp0) : CHUNK_PANELS;
            { MoeOrder S; S.cp0 = cp0; S.cpn = cpn; S.ntile = 28; S.tiles_per_exp = 28; S.G = F.G; S.c = F.bid; S.gather = true;
#pragma unroll
              for (int x = 0; x < 8; ++x) S.pend[x] = mg.pend[x];
              Gemm g{XN3, (const bf16*)(ws + WS_MOEW_GU), 1024, 1024, 1024, slot_tok}; EpiSwiglu E{MACT};
              pg8::gemm_phase<EpiSwiglu, MoeOrder, true>(F.lds, g, S, E); }
            xcd_barrier(bar);
            { MoeOrder S; S.cp0 = cp0; S.cpn = cpn; S.ntile = 4; S.tiles_per_exp = 4; S.G = F.G; S.c = F.bid; S.gather = false;
#pragma unroll
              for (int x = 0; x < 8; ++x) S.pend[x] = mg.pend[x];
              Gemm g{MACT, (const bf16*)(ws + WS_MOEW_D), FF, FF, FF, nullptr}; EpiMoeDown E{F.out, YB, slot_tok, slot_gate, cp0 * 256};
              pg8::gemm_phase<EpiMoeDown, MoeOrder, false>(F.lds, g, S, E); }
            xcd_barrier(bar);
        }
    }
    if (IN(15)) final_phase(F, A);
#undef IN
#undef SEAM
}

static int g_grid = 0;
static inline int host_setup(size_t ws_size) {
    if (g_grid) return g_grid;
    if (ws_size < WS_END) { fprintf(stderr, "kernel_launch: workspace too small: %zu < %zu\n", ws_size, (size_t)WS_END); g_grid = -1; return -1; }
    int dev = 0, cus = 0, per_cu = 0;
    if (hipGetDevice(&dev) != hipSuccess || hipDeviceGetAttribute(&cus, hipDeviceAttributeMultiprocessorCount, dev) != hipSuccess) { g_grid = -1; return -1; }
    if (hipFuncSetAttribute((const void*)mega_fwd, hipFuncAttributeMaxDynamicSharedMemorySize, LDS_BYTES) != hipSuccess) { fprintf(stderr, "kernel_launch: hipFuncSetAttribute failed\n"); g_grid = -1; return -1; }
    if (hipOccupancyMaxActiveBlocksPerMultiprocessor(&per_cu, (const void*)mega_fwd, NTHR, LDS_BYTES) != hipSuccess || per_cu < 1) fprintf(stderr, "kernel_launch: occupancy query says %d blocks per CU\n", per_cu);
    (void)hipGetLastError();
    if (cus != 256) fprintf(stderr, "kernel_launch: %d CUs (built for 256)\n", cus);
    g_grid = 256;
    return g_grid;
}
static inline void launch_range(const Args& a0, int lo, int hi, int li, hipStream_t stream) {
    Args a = a0; a.ph_lo = lo; a.ph_hi = hi; a.li = li;
    hipLaunchKernelGGL(mega_fwd, dim3(g_grid), dim3(NTHR), LDS_BYTES, stream, a);
}
}

extern "C" void kernel_launch(void* const* d_in, const int* in_sizes, int n_in, void* d_out, int out_size, void* d_ws, size_t ws_size, hipStream_t stream) {
    if (fk::host_setup(ws_size) < 0) return;
    if (hipMemsetAsync((char*)d_ws + fk::WS_CTL, 0, fk::CTL_ZERO_BYTES, stream) != hipSuccess) return;
    fk::Args a{};
    for (int i = 0; i < 23; ++i) a.in[i] = (const float*)d_in[i];
    a.out = (float*)d_out; a.ws = (unsigned char*)d_ws;
    fk::launch_range(a, 0, fk::N_PHASES, 0, stream);
}
```

```cpp
#include <hip/hip_runtime.h>
#include <cstdio>
#include <cstdint>
#include <cmath>
__device__ __forceinline__ void sincos_rev(double f, float& sn, float& cs) {
    const int k = (int)(f * 4.0 + 0.5); const double r = f - 0.25 * (double)k; const double a = 6.283185307179586476925 * r; const double a2 = a * a;
    double s = a * (1.0 + a2 * (-1.0 / 6 + a2 * (1.0 / 120 + a2 * (-1.0 / 5040 + a2 * (1.0 / 362880 + a2 * (-1.0 / 39916800 + a2 * (1.0 / 6227020800.0)))))));
    double c = 1.0 + a2 * (-0.5 + a2 * (1.0 / 24 + a2 * (-1.0 / 720 + a2 * (1.0 / 40320 + a2 * (-1.0 / 3628800 + a2 * (1.0 / 479001600.0 + a2 * (-1.0 / 87178291200.0)))))));
    const int q = k & 3; double so, co;
    if (q == 0) { so = s; co = c; } else if (q == 1) { so = c; co = -s; } else if (q == 2) { so = -s; co = -c; } else { so = -c; co = s; }
    sn = (float)so; cs = (float)co;
}
__device__ __forceinline__ void rope_cs(int pos, int i, int half, float& sn, float& cs) {
    const double r = (half == 16) ? 0.5623413251903491 : 0.7498942093324559;
    double inv = 1.0; for (int j = 0; j < i; ++j) inv *= r;
    const double rev = (double)pos * inv * 0.15915494309189533577; const double fl = (double)(long long)rev;
    sincos_rev(rev - fl, sn, cs);
}
#define GAS __attribute__((address_space(1)))
#define LAS __attribute__((address_space(3)))
#define DI __device__ __forceinline__
typedef unsigned short bf16;
typedef short bf16x8 __attribute__((ext_vector_type(8)));
typedef float f32x4 __attribute__((ext_vector_type(4)));
typedef float f32x16 __attribute__((ext_vector_type(16)));
typedef unsigned u32x4 __attribute__((ext_vector_type(4)));
typedef unsigned u32x2 __attribute__((ext_vector_type(2)));
typedef float f32x2_t __attribute__((ext_vector_type(2)));
typedef __bf16 bf16x2_t __attribute__((ext_vector_type(2)));
typedef GAS unsigned gu32;
typedef int i32x8 __attribute__((ext_vector_type(8)));
typedef int i32x4 __attribute__((ext_vector_type(4)));
#define RLX_AGENT __ATOMIC_RELAXED, __HIP_MEMORY_SCOPE_AGENT
DI unsigned pk2(float lo, float hi) { f32x2_t v = {lo, hi}; bf16x2_t b = __builtin_convertvector(v, bf16x2_t); return __builtin_bit_cast(unsigned, b); }
DI float bf_lo(unsigned u) { return __builtin_bit_cast(float, u << 16); }
DI float bf_hi(unsigned u) { return __builtin_bit_cast(float, u & 0xffff0000u); }
DI int lane_id() { int x; asm volatile("v_mbcnt_lo_u32_b32 %0, -1, 0\n\tv_mbcnt_hi_u32_b32 %0, -1, %0" : "=v"(x)); return x; }
DI float wave_sum(float v) {
#pragma unroll
    for (int o = 1; o < 64; o <<= 1) v += __shfl_xor(v, o);
    return v;
}

#define XB_TMO      128
#define XB_XCNT(j)  (256  + 64 * (j))
#define XB_XSUB(j)  (1280 + 64 * (j))
#define XB_XGEN(j)  (2304 + 64 * (j))
#define XB_TOP      3328
#define XB_TOPGEN   3392
#define XCD_BAR_WORDS 3456
#define XB_SPIN_CAP (1u << 18)

__device__ __forceinline__ unsigned xb_ld(unsigned* p)              { return __hip_atomic_load(p, __ATOMIC_RELAXED, __HIP_MEMORY_SCOPE_AGENT); }
__device__ __forceinline__ unsigned xb_add(unsigned* p, unsigned v) { return __hip_atomic_fetch_add(p, v, __ATOMIC_RELAXED, __HIP_MEMORY_SCOPE_AGENT); }
__device__ __forceinline__ unsigned xb_xcc_id() { return (unsigned)__builtin_amdgcn_s_getreg((3 << 11) | 20) & 0xFu; }
#define XB_SPIN(cond, bar) do { unsigned _sp = 0; while (cond) { __builtin_amdgcn_s_sleep(1); \
    if ((++_sp & 255u) == 0u) { if (xb_ld(&(bar)[XB_TMO])) break; if (_sp > XB_SPIN_CAP) { atomicAdd(&(bar)[XB_TMO], 1u); break; } } } } while (0)

struct XcdBarrier {
    unsigned* bar; unsigned x; unsigned w0;
    volatile LAS unsigned* st;
};

__device__ __forceinline__ XcdBarrier xcd_barrier_post(unsigned* bar, volatile LAS unsigned* st) {
    XcdBarrier b; b.bar = bar; b.x = xb_xcc_id(); b.st = st; b.w0 = (__builtin_amdgcn_readfirstlane((int)threadIdx.x >> 6) == 0) ? 1u : 0u;
    if (b.w0 && lane_id() == 0) (void)xb_add(&bar[XB_XCNT(b.x)], 1u);
    return b;
}
__device__ __forceinline__ void xcd_barrier_complete(unsigned* bar, unsigned x, unsigned& nloc, unsigned& nx) {
    const unsigned G = gridDim.x * gridDim.y * gridDim.z;
    unsigned sum, cnt, mine, sp = 0u;
    for (;;) {
        sum = 0u; cnt = 0u; mine = 0u;
#pragma unroll
        for (unsigned j = 0; j < 16; ++j) { const unsigned c = xb_ld(&bar[XB_XCNT(j)]); sum += c; cnt += (c > 0u) ? 1u : 0u; mine = (j == x) ? c : mine; }
        if (sum == G) break;
        __builtin_amdgcn_s_sleep(1);
        if ((++sp & 255u) == 0u) { if (xb_ld(&bar[XB_TMO])) break; if (sp > XB_SPIN_CAP) { atomicAdd(&bar[XB_TMO], 1u); break; } }
    }
    nloc = mine > 0u ? mine : 1u; nx = cnt > 0u ? cnt : 1u;
}

__device__ __forceinline__ void xcd_barrier(const XcdBarrier& b) {
    asm volatile("s_waitcnt vmcnt(0)" ::: "memory");
    __syncthreads();
    if (b.w0 && lane_id() == 0) {
        unsigned* bar = b.bar;
        __builtin_amdgcn_s_waitcnt(0);
        unsigned nloc = b.st[0], nx = b.st[1];
        if (nloc == 0u) { xcd_barrier_complete(bar, b.x, nloc, nx); b.st[0] = nloc; b.st[1] = nx; }
        const unsigned old = xb_add(&bar[XB_XSUB(b.x)], 1u);
        const unsigned gen = old / nloc;
        if (old + 1u == (gen + 1u) * nloc) {
            __builtin_amdgcn_fence(__ATOMIC_RELEASE, "agent");
            asm volatile("s_waitcnt vmcnt(0)" ::: "memory");
            const unsigned og = xb_add(&bar[XB_TOP], 1u);
            const unsigned tg = og / nx;
            if (og + 1u == (tg + 1u) * nx) xb_add(&bar[XB_TOPGEN], 1u);
            else XB_SPIN(xb_ld(&bar[XB_TOPGEN]) == tg, bar);
            __builtin_amdgcn_fence(__ATOMIC_ACQUIRE, "agent");
            xb_add(&bar[XB_XGEN(b.x)], 1u);
            asm volatile("s_waitcnt vmcnt(0)" ::: "memory");
        } else {
            XB_SPIN(xb_ld(&bar[XB_XGEN(b.x)]) == gen, bar);
            __builtin_amdgcn_fence(__ATOMIC_ACQUIRE, "agent");
            asm volatile("s_waitcnt vmcnt(0)" ::: "memory");
        }
    }
    __syncthreads();
}


namespace pg8 {
#define PG8_LAS __attribute__((address_space(3)))
typedef unsigned short bf16_t;
constexpr int BM = 256, BK = 64, HALF = 128, HTB = HALF * BK * 2  , STAGE_BYTES = 8 * HTB;
__host__ __device__ __forceinline__ int lds_byte(int r, int c) { const int st = (r >> 4) * 2 + (c >> 5), rr = r & 15, cc = c & 31, ob = rr * 64 + cc * 2; return st * 1024 + (ob ^ (((ob >> 9) & 1) << 5)); }
__host__ __device__ __forceinline__ void stage_rc(int b, int& R, int& C) { const int st = b / 1024, sb = b % 1024, swz = sb ^ (((sb >> 9) & 1) << 5); R = (st >> 1) * 16 + swz / 64; C = (st & 1) * 32 + (swz % 64) / 2; }
__host__ __device__ __forceinline__ int perm32(int rho) { const int n = rho >> 4, i = rho & 15; return 8 * (i >> 2) + 4 * n + (i & 3); }

struct Unit { int pm, pn, om, on, ex; };
struct Gemm { const bf16_t* A; const bf16_t* Bt; int lda, ldb, K; const unsigned* slot_tok; };

struct StaticOrder {
    int nM, nN, nwg, G, c;
    __device__ void init(int M, int N, int G_, int c_) { nM = M / BM; nN = N / BM; nwg = nM * nN; G = G_; c = c_; }
    __device__ bool next(int i, Unit& u) const {
        const long L = (long)i * G + c; if (L >= nwg) return false;
        int wgid = (int)L; { const int q = nwg / 8, r = nwg % 8, xcd = wgid % 8, off = wgid / 8; wgid = (xcd < r ? xcd * (q + 1) : r * (q + 1) + (xcd - r) * q) + off; }
        const int nig = 8 * nN, gid = wgid / nig, fm = gid * 8, gsz = (nM - fm) < 8 ? (nM - fm) : 8;
        u.pm = fm + ((wgid % nig) % gsz); u.pn = (wgid % nig) / gsz; u.om = u.pm; u.on = u.pn; u.ex = 0; return true;
    }
};

template <class Epi, class Sched, bool GATHER, bool FP8 = false>
__device__ __forceinline__ void gemm_phase(PG8_LAS unsigned char* lds, const Gemm g, const Sched& S, const Epi& E, int wave) {
    int tid = wave * 64 + lane_id(); asm volatile("" : "+v"(tid));
    const int wid = __builtin_amdgcn_readfirstlane(tid >> 6), lane = tid & 63, wr = wid >> 2, wc = wid & 3, fr = lane & 15, fq = lane >> 4;
    const int K = g.K, nt = K / BK;
    unsigned voffA[2], voffB[2];
#pragma unroll
    for (int i = 0; i < 2; ++i) { int R, C; stage_rc(tid * 16 + i * 8192, R, C); const int Rb = (R & ~31) + perm32(R & 31);
        voffA[i] = (unsigned)(R * g.lda + C) * 2u; voffB[i] = (unsigned)(Rb * g.ldb + C) * 2u; }
    const size_t kstep = (size_t)(BK * 2);
    const size_t hstepB = (size_t)HALF * g.ldb * 2, tstepB = 2 * hstepB;
    const size_t hstepA = GATHER ? (size_t)0 : (size_t)HALF * g.lda * 2, tstepA = 2 * hstepA;
    const unsigned ldsw = (unsigned)wid * 1024u;
    const int aoff = lds_byte(wr * 64 + fr, fq * 8), boff = lds_byte(wc * 32 + fr, fq * 8);
#define PG8_SA(b, h) (((b) * 2 + (h)) * HTB)
#define PG8_SB(b, h) ((4 + (b) * 2 + (h)) * HTB)
#define PG8_STAGE_B(bufoff, gbase) do { const char* _gb = (const char*)(gbase); asm volatile("" : "+s"(_gb)); _Pragma("unroll") for (int _i = 0; _i < 2; ++_i) \
        __builtin_amdgcn_global_load_lds((const unsigned*)(_gb + voffB[_i]), (PG8_LAS unsigned*)(lds + (bufoff) + ldsw + _i * 8192), 16, 0, 0); } while (0)
#define PG8_STAGE_A(bufoff, gbase, h) do { const char* _ga = (const char*)(gbase) + (size_t)(h) * hstepA; asm volatile("" : "+s"(_ga)); _Pragma("unroll") for (int _i = 0; _i < 2; ++_i) \
        __builtin_amdgcn_global_load_lds((const unsigned*)(_ga + (GATHER ? vC[h][_i] : voffA[_i])), (PG8_LAS unsigned*)(lds + (bufoff) + ldsw + _i * 8192), 16, 0, 0); } while (0)
#define PG8_SETV(V, u) do { _Pragma("unroll") for (int _h = 0; _h < 2; ++_h) _Pragma("unroll") for (int _i = 0; _i < 2; ++_i) { int _R, _C; stage_rc(tid * 16 + _i * 8192, _R, _C); \
        const unsigned _s = g.slot_tok[(size_t)(u).pm * 256 + _h * 128 + _R]; const unsigned _t = _s ? ((_s - 1u) >> 1) : 0u; (V)[_h][_i] = (_t * (unsigned)g.lda + (unsigned)_C) * 2u; } } while (0)
#define PG8_LDA(dst, b, h) do { _Pragma("unroll") for (int m = 0; m < 4; ++m) _Pragma("unroll") for (int k = 0; k < 2; ++k) dst[m][k] = *(const PG8_LAS bf16x8*)(lds + PG8_SA(b, h) + aoff + m * 2048 + k * 1024); } while (0)
#define PG8_LDB(dst, b, h) do { _Pragma("unroll") for (int n = 0; n < 2; ++n) _Pragma("unroll") for (int k = 0; k < 2; ++k) dst[n][k] = *(const PG8_LAS bf16x8*)(lds + PG8_SB(b, h) + boff + n * 2048 + k * 1024); } while (0)
#define PG8_CAT(x, y) __builtin_shufflevector(__builtin_bit_cast(i32x4, (x)), __builtin_bit_cast(i32x4, (y)), 0, 1, 2, 3, 4, 5, 6, 7)
#define PG8_MMA(ai, bj, At, Bt) do { __builtin_amdgcn_s_setprio(1); _Pragma("unroll") for (int m = 0; m < 4; ++m) _Pragma("unroll") for (int n = 0; n < 2; ++n) { \
        if constexpr (FP8) acc[ai][bj][m][n] = __builtin_amdgcn_mfma_scale_f32_16x16x128_f8f6f4(PG8_CAT(Bt[n][0], Bt[n][1]), PG8_CAT(At[m][0], At[m][1]), acc[ai][bj][m][n], 0, 0, 0, 0, 0, 0); \
        else { _Pragma("unroll") for (int k = 0; k < 2; ++k) acc[ai][bj][m][n] = __builtin_amdgcn_mfma_f32_16x16x32_bf16(Bt[n][k], At[m][k], acc[ai][bj][m][n], 0, 0, 0); } } \
        __builtin_amdgcn_s_setprio(0); } while (0)
#define PG8_WAIT_V(n) asm volatile("s_waitcnt vmcnt(" #n ")" ::: "memory")
#define PG8_WAIT_L(n) asm volatile("s_waitcnt lgkmcnt(" #n ")" ::: "memory")
#define PG8_BAR __builtin_amdgcn_s_barrier()
#define PG8_SCHED __builtin_amdgcn_sched_barrier(0)
    Unit cur, nxt; int ui = 0;
    if (!S.next(0, cur)) return;
    f32x4 acc[2][2][4][2];
#pragma unroll
    for (int a = 0; a < 2; ++a)
#pragma unroll
        for (int b = 0; b < 2; ++b)
#pragma unroll
            for (int m = 0; m < 4; ++m)
#pragma unroll
                for (int n = 0; n < 2; ++n) acc[a][b][m][n] = (f32x4){0.f, 0.f, 0.f, 0.f};
    bf16x8 At[4][2], B0[2][2], B1[2][2];
    unsigned vC[2][2];
    if (GATHER) { PG8_SETV(vC, cur); }
    PG8_LAS unsigned* const slot_stage = (PG8_LAS unsigned*)(lds + 131072 + 2048);
    const char* cA = (const char*)g.A + (size_t)cur.pm * tstepA; const char* cB = (const char*)g.Bt + (size_t)cur.pn * tstepB;
    PG8_STAGE_B(PG8_SB(0, 0), cB); PG8_STAGE_B(PG8_SB(0, 1), cB + hstepB); PG8_STAGE_A(PG8_SA(0, 0), cA, 0); PG8_STAGE_A(PG8_SA(0, 1), cA, 1);
    if (wr == 1) PG8_BAR;
    PG8_WAIT_V(2); PG8_BAR;
    PG8_STAGE_B(PG8_SB(1, 0), cB + kstep); PG8_STAGE_A(PG8_SA(1, 0), cA + kstep, 0); PG8_STAGE_B(PG8_SB(1, 1), cB + hstepB + kstep);
    PG8_WAIT_V(6); PG8_BAR;
    for (;;) {
        const bool has_next = S.next(ui + 1, nxt);
#ifdef PROBE_MASK
        if constexpr (GATHER) if (wid == 0) { const unsigned long long _pu0 = __builtin_amdgcn_s_memrealtime(); if (lane_id() == 0) ((volatile PG8_LAS unsigned long long*)(lds + 131072 + 256))[26] = _pu0; }
#endif
        const char* nA = has_next ? (const char*)g.A + (size_t)nxt.pm * tstepA : cA; const char* nB = has_next ? (const char*)g.Bt + (size_t)nxt.pn * tstepB : cB;
        if constexpr (Epi::ROWVEC) {
            cur.ex = ui & 1;
            if (wid < 4) {
#pragma unroll
                for (int _k = 0; _k < 4; ++_k) __builtin_amdgcn_global_load_lds((const unsigned*)E.ssq + (size_t)_k * E.ssq_stride + (size_t)cur.om * 256 + wid * 64 + lane,
                                                                                 (PG8_LAS unsigned*)(lds + 131072 + 8192) + (ui & 1) * 1024 + _k * 256 + wid * 64, 4, 0, 0);
            }
        }
        if (GATHER) {
            if (has_next && wid < 4) __builtin_amdgcn_global_load_lds(g.slot_tok + (size_t)nxt.pm * 256 + wid * 64 + lane, slot_stage + ((ui + 1) & 1) * 256 + wid * 64, 4, 0, 0);
        }
#pragma clang loop unroll(disable)
        for (int t = 0; t < nt; t += 2) {
            const bool last = (t == nt - 2);
            const char* a1 = cA + (size_t)(t + 1) * kstep;
            const char* a2 = last ? nA : cA + (size_t)(t + 2) * kstep; const char* b2 = last ? nB : cB + (size_t)(t + 2) * kstep;
            const char* a3 = a2 + kstep; const char* b3 = b2 + kstep;
            PG8_LDB(B0, 0, 0); PG8_LDB(B1, 0, 1); PG8_SCHED; PG8_LDA(At, 0, 0); PG8_STAGE_A(PG8_SA(1, 1), a1, 1);
            if (GATHER && last && has_next) {
#pragma unroll
                for (int _h = 0; _h < 2; ++_h)
#pragma unroll
                    for (int _i = 0; _i < 2; ++_i) { int _R, _C; stage_rc(tid * 16 + _i * 8192, _R, _C); const unsigned _s = slot_stage[((ui + 1) & 1) * 256 + _h * 128 + _R];
                        const unsigned _t = _s ? ((_s - 1u) >> 1) : 0u; vC[_h][_i] = (_t * (unsigned)g.lda + (unsigned)_C) * 2u; }
            }
            PG8_WAIT_V(8); PG8_WAIT_L(0); PG8_BAR; PG8_MMA(0, 0, At, B0); PG8_MMA(0, 1, At, B1); PG8_BAR; PG8_SCHED;
            PG8_LDA(At, 0, 1); PG8_STAGE_B(PG8_SB(0, 0), b2); PG8_STAGE_B(PG8_SB(0, 1), b2 + hstepB); PG8_STAGE_A(PG8_SA(0, 0), a2, 0);
            PG8_WAIT_V(8); PG8_WAIT_L(0); PG8_BAR; PG8_MMA(1, 0, At, B0); PG8_MMA(1, 1, At, B1); PG8_BAR; PG8_SCHED;
            PG8_LDB(B0, 1, 0); PG8_LDB(B1, 1, 1); PG8_SCHED; PG8_LDA(At, 1, 0); PG8_STAGE_A(PG8_SA(0, 1), a2, 1);
            PG8_WAIT_V(8); PG8_WAIT_L(0); PG8_BAR; PG8_MMA(0, 0, At, B0); PG8_MMA(0, 1, At, B1); PG8_BAR; PG8_SCHED;
            PG8_LDA(At, 1, 1); PG8_STAGE_B(PG8_SB(1, 0), b3); PG8_STAGE_B(PG8_SB(1, 1), b3 + hstepB); PG8_STAGE_A(PG8_SA(1, 0), a3, 0);
            PG8_WAIT_V(8); PG8_WAIT_L(0); PG8_BAR; PG8_MMA(1, 0, At, B0); PG8_MMA(1, 1, At, B1); PG8_BAR; PG8_SCHED;
        }
        if (wr == 0) PG8_BAR;
#ifdef PROBE_MASK
        unsigned long long _pe0 = 0ull; if (wid == 0) { _pe0 = __builtin_amdgcn_s_memrealtime(); volatile PG8_LAS unsigned long long* _tv2 = (volatile PG8_LAS unsigned long long*)(lds + 131072 + 256); if (GATHER && lane_id() == 0 && _tv2[23] == 1ull) _tv2[25] += _pe0 - _tv2[26]; }
#endif
        { const int _l = lane_id(); E(acc, cur, wr, wc, _l & 15, _l >> 4); }
#ifdef PROBE_MASK
        if (wid == 0) { asm volatile("s_waitcnt vmcnt(0)" ::: "memory"); const unsigned long long _pe1 = __builtin_amdgcn_s_memrealtime(); volatile PG8_LAS unsigned long long* _tv = (volatile PG8_LAS unsigned long long*)(lds + 131072 + 256);
            if (lane_id() == 0 && _tv[23] == 1ull) _tv[24] += _pe1 - _pe0; }
#endif
        if (!has_next) break;
#pragma unroll
        for (int a = 0; a < 2; ++a)
#pragma unroll
            for (int b = 0; b < 2; ++b)
#pragma unroll
                for (int m = 0; m < 4; ++m)
#pragma unroll
                    for (int n = 0; n < 2; ++n) acc[a][b][m][n] = (f32x4){0.f, 0.f, 0.f, 0.f};
        cur = nxt; cA = nA; cB = nB; ++ui;
        if (wr == 1) PG8_BAR;
    }
    PG8_WAIT_V(0);
    PG8_BAR;
#undef PG8_SA
#undef PG8_SB
#undef PG8_STAGE_A
#undef PG8_STAGE_B
#undef PG8_SETV
#undef PG8_LDA
#undef PG8_LDB
#undef PG8_MMA
#undef PG8_CAT
#undef PG8_WAIT_V
#undef PG8_WAIT_L
#undef PG8_BAR
#undef PG8_SCHED
}
}
namespace fk {
using pg8::Unit; using pg8::Gemm;
constexpr int NWAVES = 8, NTHR = 512;
constexpr int SEQ = 2048, NBATCH = 16, T = NBATCH * SEQ, DM = 1024, FF = 3584, NEXP = 8;
constexpr int AB_IN = 3744, AB_P = 3840;
constexpr int CD_IN = 2816;
constexpr int PC_QLAT = 0, PC_KVLAT = 384, PC_KROPE = 640, PC_RQ = 768, PC_RK = 1280, PC_RV = 1792, PC_RG = 2816;
constexpr int P2_SQ = 0, P2_SK = 1024, P2_SV = 1152, P2_BQ = 1280, P2_BK = 1792, P2_BV = 2304;
constexpr float EPS = 1e-6f;
constexpr float LOG2E = 1.4426950408889634f;
constexpr int MOE_CAP = 2 * T + NEXP * 256;
#ifndef FFN_DOWN_FP8
#define FFN_DOWN_FP8 1
#endif
#ifndef FFN_FP8
#define FFN_FP8 0
#endif
constexpr int CHUNK_PANELS = 128;
constexpr float W8_SCALE = 64.0f, W8_INV = 1.0f / 64.0f;

constexpr size_t MiB = 1u << 20;
constexpr size_t WS_CTL = 0, CTL_ZERO_BYTES = 1 * MiB;
constexpr size_t WS_TAB = 1 * MiB;
constexpr size_t WS_CS16 = WS_TAB, WS_CS32 = WS_TAB + 262144;
constexpr size_t WS_W = 2 * MiB;
constexpr size_t WS_W_ABIN = WS_W;
constexpr size_t WS_W_UQ = WS_W_ABIN + (size_t)AB_P * 1024 * 2;
constexpr size_t WS_W_UKV = WS_W_UQ + (size_t)768 * 384 * 2;
constexpr size_t WS_W_ABOUT = WS_W_UKV + (size_t)1024 * 256 * 2;
constexpr size_t WS_W_FGU = WS_W_ABOUT + (size_t)1024 * 1536 * 2;
constexpr size_t WS_W_FD = WS_W_FGU + (size_t)7168 * 1024 * 2;
constexpr size_t WS_W_CDIN = WS_W_FD + (size_t)1024 * 3584 * 2;
constexpr size_t WS_W_CDOUT = WS_W_CDIN + (size_t)2816 * 1024 * 2;
constexpr size_t WS_W_END = WS_W_CDOUT + (size_t)1024 * 1536 * 2;
constexpr size_t WS_SSQ = 43 * MiB + 256 * 1024;
static_assert(WS_W_END <= WS_SSQ && WS_SSQ + (size_t)4 * T * 4 <= 44 * MiB, "small weights + ssq fit [2,44) MiB");
constexpr size_t WS_ACT = 44 * MiB;
constexpr size_t WS_P = WS_ACT;
constexpr size_t WS_XN = 284 * MiB;
constexpr size_t WS_KVH = 284 * MiB;
constexpr size_t WS_Q = 348 * MiB;
constexpr size_t WS_MIXED = 396 * MiB;
constexpr size_t WS_HACT = WS_ACT;
constexpr size_t WS_P2 = WS_ACT;
constexpr size_t WS_MIXED2 = 348 * MiB;
constexpr size_t WS_MACT = WS_ACT;
constexpr size_t WS_XN3 = 156 * MiB;
constexpr size_t WS_Y0 = 188 * MiB, WS_Y1 = 348 * MiB;
constexpr size_t WS_MOEW = 461 * MiB;
constexpr size_t WS_MOEW_GU = WS_MOEW, WS_MOEW_D = WS_MOEW + (size_t)NEXP * 7168 * 1024;
constexpr size_t WS_END = 545 * MiB;
static_assert(WS_MOEW_D + (size_t)NEXP * 1024 * 3584 <= WS_END, "ws map end");
constexpr int CW_TMO = 0, CW_CODE = 1;
constexpr int CW_QUEUE = 64;
constexpr int CW_PROBE = 2048;
constexpr int CW_ECNT = 1024;
constexpr int CW_BAR = 4096;
constexpr int CW_SLOT_TOK = 65536;
constexpr int CW_SLOT_GATE = CW_SLOT_TOK + MOE_CAP;
constexpr int CW_TAILFLAG = 204800;
static_assert(CW_SLOT_GATE + MOE_CAP <= CW_TAILFLAG && (size_t)CW_TAILFLAG * 4 + (size_t)T * 4 <= CTL_ZERO_BYTES, "ctl fits");
static_assert(CW_BAR + 16 * 3456 <= CW_SLOT_TOK, "barrier regions");

constexpr int RING_BYTES = 131072;
constexpr int MISC_OFF = RING_BYTES;
constexpr int LDS_BYTES = 147456;

struct Frame {
    LAS unsigned char* lds;
    volatile LAS unsigned* MISC;
    gu32* ctl;
    unsigned char* ws;
    int wave, G, bid;
    float* out;
};
struct Args { const float* in[23]; float* out; unsigned char* ws; int ph_lo, ph_hi, li, pad; };

DI unsigned pk4_fp8(float a, float b, float c, float d) { int w = 0; w = __builtin_amdgcn_cvt_pk_fp8_f32(a, b, w, false); w = __builtin_amdgcn_cvt_pk_fp8_f32(c, d, w, true); return (unsigned)w; }
DI float row_rstd_lds(LAS unsigned char* lds, int par, int lrow) { const LAS float* st = (const LAS float*)(lds + 131072 + 8192) + par * 1024 + lrow; return __builtin_amdgcn_rsqf((st[0] + st[256] + st[512] + st[768]) * (1.0f / DM) + EPS); }
DI float row_rstd(const float* ssq, int row) { return 1.0f / sqrtf((ssq[row] + ssq[T + row] + ssq[2 * T + row] + ssq[3 * T + row]) * (1.0f / DM) + EPS); }
template <bool RV> struct EpiBf16T {
    static constexpr bool ROWVEC = RV; static constexpr int ssq_stride = T;
    bf16* O; int ldc; const float* ssq; LAS unsigned char* lds;
    DI void operator()(const f32x4 (&acc)[2][2][4][2], const Unit& u, int wr, int wc, int fr, int fq) const {
        const int row0 = u.om * 256 + wr * 64 + fr, col0 = u.on * 256 + wc * 32 + 8 * fq;
#pragma unroll
        for (int ai = 0; ai < 2; ++ai)
#pragma unroll
            for (int m = 0; m < 4; ++m) { bf16* rowp = O + (size_t)(row0 + ai * 128 + m * 16) * ldc + col0; const float rs = RV ? row_rstd_lds(lds, u.ex, wr * 64 + fr + ai * 128 + m * 16) : 1.0f;
#pragma unroll
                for (int bj = 0; bj < 2; ++bj) { const f32x4 v0 = acc[ai][bj][m][0] * rs, v1 = acc[ai][bj][m][1] * rs;
                    u32x4 w; w.x = pk2(v0[0], v0[1]); w.y = pk2(v0[2], v0[3]); w.z = pk2(v1[0], v1[1]); w.w = pk2(v1[2], v1[3]);
                    *(u32x4*)(rowp + bj * 128) = w; } }
    }
};
typedef EpiBf16T<false> EpiBf16; typedef EpiBf16T<true> EpiBf16R;
struct EpiP {
    static constexpr bool ROWVEC = false;
    bf16* O; const float2* cs32;
    DI void operator()(const f32x4 (&acc)[2][2][4][2], const Unit& u, int wr, int wc, int fr, int fq) const {
        const int row0 = u.om * 256 + wr * 64 + fr;
        if (u.on < 3 || u.on > 6) {
            const int col0 = u.on * 256 + wc * 32 + 8 * fq;
#pragma unroll
            for (int ai = 0; ai < 2; ++ai)
#pragma unroll
                for (int m = 0; m < 4; ++m) { bf16* rowp = O + (size_t)(row0 + ai * 128 + m * 16) * AB_P + col0;
#pragma unroll
                    for (int bj = 0; bj < 2; ++bj) { const f32x4 v0 = acc[ai][bj][m][0], v1 = acc[ai][bj][m][1];
                        u32x4 w; w.x = pk2(v0[0], v0[1]); w.y = pk2(v0[2], v0[3]); w.z = pk2(v1[0], v1[1]); w.w = pk2(v1[2], v1[3]);
                        *(u32x4*)(rowp + bj * 128) = w; } }
        } else {
            const int which = u.on >= 5, head = 4 * ((u.on - 3) & 1) + wc, i0 = 8 * fq;
            const float lg2 = log1pf(-__builtin_amdgcn_exp2f(-5.0f - (float)head)) * LOG2E;
            bf16* obase = O + (which ? PC_RK : PC_RQ) + head * 64 + i0;
#pragma unroll
            for (int ai = 0; ai < 2; ++ai)
#pragma unroll
                for (int m = 0; m < 4; ++m) { const int row = row0 + ai * 128 + m * 16; const int pos = row & (SEQ - 1); const float ql = (float)(pos & 127);
                    const float sc = which ? 0.125f * __builtin_amdgcn_exp2f(-ql * lg2) : __builtin_amdgcn_exp2f(ql * lg2);
                    const float2* cs = cs32 + pos * 32 + i0;
                    float o1[8], o2[8];
#pragma unroll
                    for (int n = 0; n < 2; ++n)
#pragma unroll
                        for (int j = 0; j < 4; ++j) { const float2 t = cs[n * 4 + j]; const float x1 = acc[ai][0][m][n][j], x2 = acc[ai][1][m][n][j];
                            o1[n * 4 + j] = (x1 * t.x - x2 * t.y) * sc; o2[n * 4 + j] = (x1 * t.y + x2 * t.x) * sc; }
                    u32x4 w1, w2; w1.x = pk2(o1[0], o1[1]); w1.y = pk2(o1[2], o1[3]); w1.z = pk2(o1[4], o1[5]); w1.w = pk2(o1[6], o1[7]);
                    w2.x = pk2(o2[0], o2[1]); w2.y = pk2(o2[2], o2[3]); w2.z = pk2(o2[4], o2[5]); w2.w = pk2(o2[6], o2[7]);
                    bf16* qp = obase + (size_t)row * AB_P;
                    *(u32x4*)(qp) = w1; *(u32x4*)(qp + 32) = w2; }
        }
    }
};
struct EpiQ {
    static constexpr bool ROWVEC = false;
    bf16* Q; const float2* cs16;
    DI void operator()(const f32x4 (&acc)[2][2][4][2], const Unit& u, int wr, int wc, int fr, int fq) const {
        const int row0 = u.om * 256 + wr * 64 + fr;
        if (u.on < 2) {
#pragma unroll
            for (int ai = 0; ai < 2; ++ai)
#pragma unroll
                for (int m = 0; m < 4; ++m) { const int row = row0 + ai * 128 + m * 16;
#pragma unroll
                    for (int bj = 0; bj < 2; ++bj) { const int c = bj * 128 + wc * 32 + 8 * fq; const int hd = 4 * u.on + (c >> 6), d = c & 63;
                        const f32x4 v0 = acc[ai][bj][m][0], v1 = acc[ai][bj][m][1];
                        u32x4 w; w.x = pk2(v0[0], v0[1]); w.y = pk2(v0[2], v0[3]); w.z = pk2(v1[0], v1[1]); w.w = pk2(v1[2], v1[3]);
                        *(u32x4*)(Q + (size_t)row * 768 + hd * 96 + d) = w; } }
        } else {
            const int c = wc * 32 + 8 * fq; const int hd = c >> 4, i0 = c & 15;
#pragma unroll
            for (int ai = 0; ai < 2; ++ai)
#pragma unroll
                for (int m = 0; m < 4; ++m) { const int row = row0 + ai * 128 + m * 16; const int pos = row & (SEQ - 1);
                    const float2* cs = cs16 + pos * 16 + i0;
                    float o1[8], o2[8];
#pragma unroll
                    for (int n = 0; n < 2; ++n)
#pragma unroll
                        for (int j = 0; j < 4; ++j) { const float2 t = cs[n * 4 + j]; const float x1 = acc[ai][0][m][n][j], x2 = acc[ai][1][m][n][j];
                            o1[n * 4 + j] = x1 * t.x - x2 * t.y; o2[n * 4 + j] = x1 * t.y + x2 * t.x; }
                    u32x4 w1, w2; w1.x = pk2(o1[0], o1[1]); w1.y = pk2(o1[2], o1[3]); w1.z = pk2(o1[4], o1[5]); w1.w = pk2(o1[6], o1[7]);
                    w2.x = pk2(o2[0], o2[1]); w2.y = pk2(o2[2], o2[3]); w2.z = pk2(o2[4], o2[5]); w2.w = pk2(o2[6], o2[7]);
                    bf16* qp = Q + (size_t)row * 768 + hd * 96 + 64 + i0;
                    *(u32x4*)(qp) = w1; *(u32x4*)(qp + 16) = w2; }
        }
    }
};
struct EpiResid {
    static constexpr bool ROWVEC = false;
    const float* R; float* O; float sc;
    DI void operator()(const f32x4 (&acc)[2][2][4][2], const Unit& u, int wr, int wc, int fr, int fq) const {
        const int row0 = u.om * 256 + wr * 64 + fr, col0 = u.on * 256 + wc * 32 + 8 * fq;
#pragma unroll
        for (int ai = 0; ai < 2; ++ai)
#pragma unroll
            for (int m = 0; m < 4; ++m) { const size_t off = (size_t)(row0 + ai * 128 + m * 16) * DM + col0;
#pragma unroll
                for (int bj = 0; bj < 2; ++bj) { const f32x4 r0 = *(const f32x4*)(R + off + bj * 128), r1 = *(const f32x4*)(R + off + bj * 128 + 4);
                    *(f32x4*)(O + off + bj * 128) = r0 + acc[ai][bj][m][0] * sc; *(f32x4*)(O + off + bj * 128 + 4) = r1 + acc[ai][bj][m][1] * sc; } }
    }
};
template <bool RB16> struct EpiResidNormT {
    static constexpr bool ROWVEC = false;
    const float* R; bf16* HB; float* ssq; float sc; LAS unsigned char* lds; int xf;
    DI void operator()(const f32x4 (&acc)[2][2][4][2], const Unit& u, int wr, int wc, int fr, int fq) const {
        const int row0 = u.om * 256 + wr * 64 + fr, col0 = u.on * 256 + wc * 32 + 8 * fq;
        LAS float* tab = (LAS float*)(lds + 131072 + 4096);
#pragma unroll
        for (int ai = 0; ai < 2; ++ai)
#pragma unroll
            for (int m = 0; m < 4; ++m) { const size_t off = (size_t)(row0 + ai * 128 + m * 16) * DM + col0; float ss = 0.f;
#pragma unroll
                for (int bj = 0; bj < 2; ++bj) { f32x4 r0, r1;
                    if constexpr (RB16) { const u32x4 rb = *(const u32x4*)(HB + off + bj * 128); r0 = (f32x4){bf_lo(rb.x), bf_hi(rb.x), bf_lo(rb.y), bf_hi(rb.y)}; r1 = (f32x4){bf_lo(rb.z), bf_hi(rb.z), bf_lo(rb.w), bf_hi(rb.w)}; }
                    else { const int rw = row0 + ai * 128 + m * 16; const size_t ro = xf ? (size_t)((rw & ~(SEQ - 1)) | (SEQ - 1 - (rw & (SEQ - 1)))) * DM + col0 : off; const float sg = xf ? -1.0f : 1.0f;
                        r0 = *(const f32x4*)(R + ro + bj * 128) * sg; r1 = *(const f32x4*)(R + ro + bj * 128 + 4) * sg; }
                    const f32x4 v0 = r0 + acc[ai][bj][m][0] * sc, v1 = r1 + acc[ai][bj][m][1] * sc;
                    u32x4 w; w.x = pk2(v0[0], v0[1]); w.y = pk2(v0[2], v0[3]); w.z = pk2(v1[0], v1[1]); w.w = pk2(v1[2], v1[3]);
                    *(u32x4*)(HB + off + bj * 128) = w;
                    ss += (v0[0] * v0[0] + v0[1] * v0[1]) + (v0[2] * v0[2] + v0[3] * v0[3]) + (v1[0] * v1[0] + v1[1] * v1[1]) + (v1[2] * v1[2] + v1[3] * v1[3]); }
                ss += __shfl_xor(ss, 16); ss += __shfl_xor(ss, 32);
                if (fq == 0) tab[wc * 256 + ai * 128 + wr * 64 + m * 16 + fr] = ss; }
        asm volatile("s_waitcnt lgkmcnt(0)" ::: "memory"); __builtin_amdgcn_s_barrier();
        const int t = (wr * 4 + wc) * 64 + fq * 16 + fr;
        if (t < 256) ssq[(size_t)u.on * T + u.om * 256 + t] = (tab[t] + tab[256 + t]) + (tab[512 + t] + tab[768 + t]);
    }
};
struct EpiResidB16 {
    static constexpr bool ROWVEC = false;
    bf16* HB; float sc;
    DI void operator()(const f32x4 (&acc)[2][2][4][2], const Unit& u, int wr, int wc, int fr, int fq) const {
        const int row0 = u.om * 256 + wr * 64 + fr, col0 = u.on * 256 + wc * 32 + 8 * fq;
#pragma unroll
        for (int ai = 0; ai < 2; ++ai)
#pragma unroll
            for (int m = 0; m < 4; ++m) { const size_t off = (size_t)(row0 + ai * 128 + m * 16) * DM + col0;
#pragma unroll
                for (int bj = 0; bj < 2; ++bj) { const u32x4 rb = *(const u32x4*)(HB + off + bj * 128);
                    const f32x4 v0 = (f32x4){bf_lo(rb.x), bf_hi(rb.x), bf_lo(rb.y), bf_hi(rb.y)} + acc[ai][bj][m][0] * sc, v1 = (f32x4){bf_lo(rb.z), bf_hi(rb.z), bf_lo(rb.w), bf_hi(rb.w)} + acc[ai][bj][m][1] * sc;
                    u32x4 w; w.x = pk2(v0[0], v0[1]); w.y = pk2(v0[2], v0[3]); w.z = pk2(v1[0], v1[1]); w.w = pk2(v1[2], v1[3]);
                    *(u32x4*)(HB + off + bj * 128) = w; } }
    }
};
DI float silu_f(float x) { return x * __builtin_amdgcn_rcpf(1.0f + __builtin_amdgcn_exp2f(-x * LOG2E)); }
template <bool OUT8> struct EpiSwigluT {
    static constexpr bool ROWVEC = true; static constexpr int ssq_stride = T;
    bf16* O; const float* ssq; LAS unsigned char* lds;
    DI void operator()(const f32x4 (&acc)[2][2][4][2], const Unit& u, int wr, int wc, int fr, int fq) const {
        const int row0 = u.om * 256 + wr * 64 + fr, col0 = u.on * 128 + wc * 32 + 8 * fq;
#pragma unroll
        for (int ai = 0; ai < 2; ++ai)
#pragma unroll
            for (int m = 0; m < 4; ++m) { bf16* rowp = O + (size_t)(row0 + ai * 128 + m * 16) * FF + col0; const float rs = row_rstd_lds(lds, u.ex, wr * 64 + fr + ai * 128 + m * 16);
                float o[8];
#pragma unroll
                for (int n = 0; n < 2; ++n)
#pragma unroll
                    for (int j = 0; j < 4; ++j) o[n * 4 + j] = silu_f(acc[ai][0][m][n][j] * rs) * (acc[ai][1][m][n][j] * rs);
                if constexpr (OUT8) { u32x2 w8; w8.x = pk4_fp8(o[0], o[1], o[2], o[3]); w8.y = pk4_fp8(o[4], o[5], o[6], o[7]); *(u32x2*)((unsigned char*)O + (size_t)(row0 + ai * 128 + m * 16) * FF + col0) = w8; }
                else { u32x4 w; w.x = pk2(o[0], o[1]); w.y = pk2(o[2], o[3]); w.z = pk2(o[4], o[5]); w.w = pk2(o[6], o[7]); *(u32x4*)rowp = w; } }
    }
};
typedef EpiSwigluT<false> EpiSwiglu; typedef EpiSwigluT<true> EpiSwigluO8;
struct EpiSwiglu8 {
    static constexpr bool ROWVEC = false;
    unsigned char* O;
    DI void operator()(const f32x4 (&acc)[2][2][4][2], const Unit& u, int wr, int wc, int fr, int fq) const {
        const int row0 = u.om * 256 + wr * 64 + fr, col0 = u.on * 128 + wc * 32 + 8 * fq;
#pragma unroll
        for (int ai = 0; ai < 2; ++ai)
#pragma unroll
            for (int m = 0; m < 4; ++m) { unsigned char* rowp = O + (size_t)(row0 + ai * 128 + m * 16) * FF + col0;
                float o[8];
#pragma unroll
                for (int n = 0; n < 2; ++n)
#pragma unroll
                    for (int j = 0; j < 4; ++j) o[n * 4 + j] = silu_f(acc[ai][0][m][n][j] * W8_INV) * (acc[ai][1][m][n][j] * W8_INV);
                u32x2 w; w.x = pk4_fp8(o[0], o[1], o[2], o[3]); w.y = pk4_fp8(o[4], o[5], o[6], o[7]);
                *(u32x2*)rowp = w; }
    }
};
struct EpiMoeDown {
    static constexpr bool ROWVEC = false;
    bf16* Y0; long long ydelta; const unsigned* slot_tok; const float* slot_gate; int slot_base;
    DI void operator()(const f32x4 (&acc)[2][2][4][2], const Unit& u, int wr, int wc, int fr, int fq) const {
        const int row0 = u.om * 256 + wr * 64 + fr, col0 = u.on * 256 + wc * 32 + 8 * fq;
#pragma unroll
        for (int ai = 0; ai < 2; ++ai)
#pragma unroll
            for (int m = 0; m < 4; ++m) { const int slot = slot_base + row0 + ai * 128 + m * 16; const unsigned s = slot_tok[slot];
                if (s) { const unsigned tk = s - 1u; const size_t off = (size_t)(tk >> 1) * DM + col0; bf16* Y = Y0 + (long long)(tk & 1u) * ydelta; const float gt = slot_gate[slot] * W8_INV;
#pragma unroll
                    for (int bj = 0; bj < 2; ++bj) { const f32x4 v0 = acc[ai][bj][m][0] * gt, v1 = acc[ai][bj][m][1] * gt;
                        u32x4 w; w.x = pk2(v0[0], v0[1]); w.y = pk2(v0[2], v0[3]); w.z = pk2(v1[0], v1[1]); w.w = pk2(v1[2], v1[3]);
                        *(u32x4*)(Y + off + bj * 128) = w; } } }
    }
};

DI void conv_item(const float* W, int N, bf16* WT, int ldk, int dst_row0, int src_col0, int k0, float scale, LAS float* scr, int lane, const float* kgain = nullptr) {
    if (src_col0 >= 0) {
        float wv[32];
#pragma unroll
        for (int i = 0; i < 32; ++i) { const int kk = 2 * i + (lane >> 5); wv[i] = __builtin_nontemporal_load(W + (size_t)(k0 + kk) * N + src_col0 + (lane & 31));        }
#pragma unroll
        for (int i = 0; i < 32; ++i) { const int kk = 2 * i + (lane >> 5); scr[kk * 33 + (lane & 31)] = wv[i] * (kgain ? scale * kgain[k0 + kk] : scale); }
    } else {
#pragma unroll 8
        for (int i = 0; i < 32; ++i) { const int kk = 2 * i + (lane >> 5); scr[kk * 33 + (lane & 31)] = 0.f; }
    }
    asm volatile("s_waitcnt lgkmcnt(0)" ::: "memory");
    const int c = lane & 7;
#pragma unroll
    for (int j = 0; j < 4; ++j) { const int n = (lane >> 3) + 8 * j; const LAS float* s = scr + (8 * c) * 33 + n;
        u32x4 o; o.x = pk2(s[0 * 33], s[1 * 33]); o.y = pk2(s[2 * 33], s[3 * 33]); o.z = pk2(s[4 * 33], s[5 * 33]); o.w = pk2(s[6 * 33], s[7 * 33]);
        *(GAS u32x4*)(WT + (size_t)(dst_row0 + n) * ldk + k0 + 8 * c) = o; }
    asm volatile("s_waitcnt lgkmcnt(0)" ::: "memory");
}
DI void conv_item8(const float* W, int N, unsigned char* WT, int ldk, int dst_row0, int src_col0, int k0, float scale, LAS float* scr, int lane) {
    float wv[32];
#pragma unroll
    for (int i = 0; i < 32; ++i) { const int kk = 2 * i + (lane >> 5); wv[i] = __builtin_nontemporal_load(W + (size_t)(k0 + kk) * N + src_col0 + (lane & 31));        }
#pragma unroll
    for (int i = 0; i < 32; ++i) { const int kk = 2 * i + (lane >> 5); scr[kk * 33 + (lane & 31)] = wv[i] * scale; }
    asm volatile("s_waitcnt lgkmcnt(0)" ::: "memory");
    const int n = lane >> 1, kh = (lane & 1) * 32; const LAS float* sp = scr + kh * 33 + n;
    u32x4 o0, o1;
    o0.x = pk4_fp8(sp[0 * 33], sp[1 * 33], sp[2 * 33], sp[3 * 33]); o0.y = pk4_fp8(sp[4 * 33], sp[5 * 33], sp[6 * 33], sp[7 * 33]);
    o0.z = pk4_fp8(sp[8 * 33], sp[9 * 33], sp[10 * 33], sp[11 * 33]); o0.w = pk4_fp8(sp[12 * 33], sp[13 * 33], sp[14 * 33], sp[15 * 33]);
    o1.x = pk4_fp8(sp[16 * 33], sp[17 * 33], sp[18 * 33], sp[19 * 33]); o1.y = pk4_fp8(sp[20 * 33], sp[21 * 33], sp[22 * 33], sp[23 * 33]);
    o1.z = pk4_fp8(sp[24 * 33], sp[25 * 33], sp[26 * 33], sp[27 * 33]); o1.w = pk4_fp8(sp[28 * 33], sp[29 * 33], sp[30 * 33], sp[31 * 33]);
    GAS unsigned char* dp = (GAS unsigned char*)WT + (size_t)(dst_row0 + n) * ldk + k0 + kh;
    *(GAS u32x4*)dp = o0; *(GAS u32x4*)(dp + 16) = o1;
    asm volatile("s_waitcnt lgkmcnt(0)" ::: "memory");
}
DI void conv_matrix_item8(const float* W, int K, int N, unsigned char* WT, int mode, float scale, LAS float* scr, int item, int lane) {
    const int nblk = N / 32, kb = item / nblk, nb = item % nblk, src0 = nb * 32;
    conv_item8(W, N, WT, K, (mode == 2) ? ((src0 >> 7) * 256 + (src0 & 127)) : (mode == 3) ? ((src0 >> 7) * 256 + 128 + (src0 & 127)) : src0, src0, kb * 64, scale, scr, lane);
}
DI int conv_dst1(int src) {
    if (src < 672) return src;
    if (src >= 1696) return src + 96;
    const int rk = src >= 1184, rel = src - (rk ? 1184 : 672), head = rel >> 6, half = (rel >> 5) & 1, i = rel & 31;
    return (rk ? 1280 : 768) + (head >> 2) * 256 + half * 128 + (head & 3) * 32 + i;
}
DI int conv_dst(int mode, int src) { return (mode == 0 || mode == 4) ? src : mode == 1 ? conv_dst1(src) : mode == 2 ? ((src >> 7) * 256 + (src & 127)) : ((src >> 7) * 256 + 128 + (src & 127)); }
DI float conv_scale(int mode, int src) { return mode != 4 ? 1.0f : (src < 1024 ? 0.125f * LOG2E : ((src >= 1280 && src < 1792) ? 0.125f : 1.0f)); }
DI void conv_matrix_item(const float* W, int K, int N, bf16* WT, int mode, LAS float* scr, int item, int lane, const float* kgain = nullptr) {
    const int nblk = N / 32, kb = item / nblk, nb = item % nblk, src0 = nb * 32;
    conv_item(W, N, WT, K, conv_dst(mode, src0), src0, kb * 64, conv_scale(mode, src0), scr, lane, kgain);
}

DI void rms_row_to_bf16(const float* xrow, const float* g, bf16* orow, int lane) {
    const GAS f32x4* xr = (const GAS f32x4*)xrow + lane; const GAS f32x4* gr = (const GAS f32x4*)g + lane;
    f32x4 v[4]; float s = 0.f;
#pragma unroll
    for (int j = 0; j < 4; ++j) { v[j] = xr[64 * j]; s += (v[j].x * v[j].x + v[j].y * v[j].y) + (v[j].z * v[j].z + v[j].w * v[j].w); }
    const float rs = 1.0f / sqrtf(wave_sum(s) * (1.f / DM) + EPS);
    GAS u32x2* o8 = (GAS u32x2*)orow + lane;
#pragma unroll
    for (int j = 0; j < 4; ++j) { const f32x4 gg = gr[64 * j]; u32x2 o; o.x = pk2(v[j].x * rs * gg.x, v[j].y * rs * gg.y); o.y = pk2(v[j].z * rs * gg.z, v[j].w * rs * gg.w); o8[64 * j] = o; }
}
DI void rms_rows2_to_bf16(const float* x0, const float* x1, const float* g, bf16* o0, bf16* o1, int lane, float sgn = 1.0f) {
    const GAS f32x4* xr0 = (const GAS f32x4*)x0 + lane; const GAS f32x4* xr1 = (const GAS f32x4*)x1 + lane; const GAS f32x4* gr = (const GAS f32x4*)g + lane;
    f32x4 v[4], u[4];
#pragma unroll
    for (int j = 0; j < 4; ++j) { v[j] = xr0[64 * j]; u[j] = xr1[64 * j]; }
    float s = 0.f, t = 0.f;
#pragma unroll
    for (int j = 0; j < 4; ++j) { s += (v[j].x * v[j].x + v[j].y * v[j].y) + (v[j].z * v[j].z + v[j].w * v[j].w); t += (u[j].x * u[j].x + u[j].y * u[j].y) + (u[j].z * u[j].z + u[j].w * u[j].w); }
    const float rs = sgn / sqrtf(wave_sum(s) * (1.f / DM) + EPS), rt = sgn / sqrtf(wave_sum(t) * (1.f / DM) + EPS);
    GAS u32x2* p0 = (GAS u32x2*)o0 + lane; GAS u32x2* p1 = (GAS u32x2*)o1 + lane;
#pragma unroll
    for (int j = 0; j < 4; ++j) { const f32x4 gg = gr[64 * j]; u32x2 a, b; a.x = pk2(v[j].x * rs * gg.x, v[j].y * rs * gg.y); a.y = pk2(v[j].z * rs * gg.z, v[j].w * rs * gg.w);
        b.x = pk2(u[j].x * rt * gg.x, u[j].y * rt * gg.y); b.y = pk2(u[j].z * rt * gg.z, u[j].w * rt * gg.w); p0[64 * j] = a; p1[64 * j] = b; }
}
DI void rms_row_to_fp8(const float* xrow, const float* g, unsigned char* orow, int lane) {
    const GAS f32x4* xr = (const GAS f32x4*)xrow + lane; const GAS f32x4* gr = (const GAS f32x4*)g + lane;
    f32x4 v[4]; float s = 0.f;
#pragma unroll
    for (int j = 0; j < 4; ++j) { v[j] = xr[64 * j]; s += (v[j].x * v[j].x + v[j].y * v[j].y) + (v[j].z * v[j].z + v[j].w * v[j].w); }
    const float rs = 1.0f / sqrtf(wave_sum(s) * (1.f / DM) + EPS);
    GAS unsigned* o4 = (GAS unsigned*)orow + lane;
#pragma unroll
    for (int j = 0; j < 4; ++j) { const f32x4 gg = gr[64 * j]; o4[64 * j] = pk4_fp8(v[j].x * rs * gg.x, v[j].y * rs * gg.y, v[j].z * rs * gg.z, v[j].w * rs * gg.w); }
}
}
namespace fk {
#define MFMA32(a, b, c) __builtin_amdgcn_mfma_f32_32x32x16_bf16((a), (b), (c), 0, 0, 0)
DI int crow(int i, int h) { return (i & 3) + 8 * (i >> 2) + 4 * h; }
DI int kvpos(int kv) { return (kv & ~12) | ((kv & 4) << 1) | ((kv & 8) >> 1); }
template <int S> DI bf16x8 pack8(const f32x16& x) { u32x4 p; p.x = pk2(x[8 * S], x[8 * S + 1]); p.y = pk2(x[8 * S + 2], x[8 * S + 3]); p.z = pk2(x[8 * S + 4], x[8 * S + 5]); p.w = pk2(x[8 * S + 6], x[8 * S + 7]); return __builtin_bit_cast(bf16x8, p); }
DI f32x16 zero16() { f32x16 z;
#pragma unroll
    for (int i = 0; i < 16; ++i) z[i] = 0.f;
    return z; }
DI float ex2(float x) { return __builtin_amdgcn_exp2f(x); }

template <int NST> DI void qk_tile(const LAS unsigned char* Kb, int kstr, const bf16x8* qf, f32x16& p0, f32x16& p1, int r, int hh) {
    p0 = zero16(); p1 = zero16();
    const LAS unsigned char* k0p = Kb + r * kstr + hh * 16; const LAS unsigned char* k1p = k0p + 32 * kstr;
#pragma unroll
    for (int st = 0; st < NST; ++st) { const bf16x8 a0 = *(const LAS bf16x8*)(k0p + st * 32); const bf16x8 a1 = *(const LAS bf16x8*)(k1p + st * 32);
        p0 = MFMA32(a0, qf[st], p0); p1 = MFMA32(a1, qf[st], p1); }
}
typedef short v4i16_t __attribute__((ext_vector_type(4)));
DI bf16x8 tr_frag(const LAS unsigned char* p, int hi_off) {
    const v4i16_t lo = __builtin_amdgcn_ds_read_tr16_b64_v4i16((LAS v4i16_t*)p), hi = __builtin_amdgcn_ds_read_tr16_b64_v4i16((LAS v4i16_t*)(p + hi_off));
    return (bf16x8){lo[0], lo[1], lo[2], lo[3], hi[0], hi[1], hi[2], hi[3]};
}
DI int tr_lane_off(int lane, int stride, int hh_mul) { const int i = lane & 15, q = i >> 2, pp = i & 3, g1 = (lane >> 4) & 1, hh = lane >> 5; return (hh_mul * hh + q) * stride + (16 * g1 + 4 * pp) * 2; }
template <int NDB> DI void pv_tile(const LAS unsigned char* Vb, int vstr, const f32x16& p0, const f32x16& p1, f32x16* o, int lane) {
    const LAS unsigned char* vp = Vb + tr_lane_off(lane, vstr, 4);
#define FK_PVSTEP(P, A, S) { const bf16x8 pp = pack8<S>(P); _Pragma("unroll") for (int db = 0; db < NDB; ++db) { \
        const bf16x8 vf = tr_frag(vp + (32 * (A) + 16 * (S)) * vstr + db * 64, 8 * vstr); o[db] = MFMA32(vf, pp, o[db]); } }
    FK_PVSTEP(p0, 0, 0) FK_PVSTEP(p0, 0, 1) FK_PVSTEP(p1, 1, 0) FK_PVSTEP(p1, 1, 1)
#undef FK_PVSTEP
}
template <int NDB> DI void softmax_step(f32x16& p0, f32x16& p1, float& m, float& l, f32x16* o) {
    float mx = p0[0];
#pragma unroll
    for (int i = 1; i < 16; ++i) mx = fmaxf(mx, p0[i]);
#pragma unroll
    for (int i = 0; i < 16; ++i) mx = fmaxf(mx, p1[i]);
    mx = fmaxf(mx, __shfl_xor(mx, 32));
    const float mn = fmaxf(m, mx); const float alpha = ex2(m - mn); float s = 0.f;
#pragma unroll
    for (int i = 0; i < 16; ++i) { p0[i] = ex2(p0[i] - mn); s += p0[i]; }
#pragma unroll
    for (int i = 0; i < 16; ++i) { p1[i] = ex2(p1[i] - mn); s += p1[i]; }
    l = l * alpha + s; m = mn;
#pragma unroll
    for (int db = 0; db < NDB; ++db) o[db] *= alpha;
}
DI void store_o64(bf16* orow, const f32x16* o, float sc, int hh) {
#pragma unroll
    for (int db = 0; db < 2; ++db)
#pragma unroll
        for (int g4 = 0; g4 < 4; ++g4) { u32x2 w; w.x = pk2(o[db][4 * g4] * sc, o[db][4 * g4 + 1] * sc); w.y = pk2(o[db][4 * g4 + 2] * sc, o[db][4 * g4 + 3] * sc);
            *(u32x2*)(orow + 32 * db + 8 * g4 + 4 * hh) = w; }
}
DI void tr_write8(LAS unsigned char* img, int stride, int row0, int pos, const u32x4& v) {
#pragma unroll
    for (int e = 0; e < 8; ++e) *(LAS unsigned short*)(img + (row0 + e) * stride + pos * 2) = (unsigned short)(v[e >> 1] >> (16 * (e & 1)));
}

DI int queue_first(Frame& F, int q) {
    __syncthreads();
    if ((F.wave * 64 + lane_id()) == 0) F.MISC[16] = __hip_atomic_fetch_add(F.ctl + CW_QUEUE + 64 * q, 1u, RLX_AGENT);
    __syncthreads();
    return (int)F.MISC[16];
}
#ifndef QUEUE_LOOKAHEAD
#define QUEUE_LOOKAHEAD 0
#endif
DI unsigned queue_post(Frame& F, int q) {
    if (!QUEUE_LOOKAHEAD) return 0u;
    unsigned v = 0u;
    if ((F.wave * 64 + lane_id()) == 0) v = __hip_atomic_fetch_add(F.ctl + CW_QUEUE + 64 * q, 1u, RLX_AGENT);
    return v;
}
DI int queue_take(Frame& F, unsigned v, int q) {
    if (!QUEUE_LOOKAHEAD) return queue_first(F, q);
    if ((F.wave * 64 + lane_id()) == 0) F.MISC[17] = v;
    __syncthreads();
    const int r = (int)F.MISC[17];
    __syncthreads();
    return r;
}

template <int NR> DI void p_post_rows(bf16* const (&Prow)[NR], const int (&pos)[NR], const float* qn, const float* kvn, const float2* cs16, int lane) {
    u32x4 vq[NR], vkv[NR]; unsigned kr1[NR], kr2[NR]; float2 t16[NR];
#pragma unroll
    for (int x = 0; x < NR; ++x) {
        vq[x] = (u32x4){0u, 0u, 0u, 0u}; if (lane < 48) vq[x] = *(const u32x4*)(Prow[x] + PC_QLAT + lane * 8);
        vkv[x] = (u32x4){0u, 0u, 0u, 0u}; if (lane < 32) vkv[x] = *(const u32x4*)(Prow[x] + PC_KVLAT + lane * 8);
        kr1[x] = 0u; kr2[x] = 0u; t16[x] = make_float2(1.f, 0.f);
        if (lane < 16) { kr1[x] = (unsigned)Prow[x][PC_KROPE + lane]; kr2[x] = (unsigned)Prow[x][PC_KROPE + 16 + lane]; t16[x] = cs16[pos[x] * 16 + lane]; }
    }
    f32x4 gq0 = (f32x4){0.f, 0.f, 0.f, 0.f}, gq1 = gq0, gk0 = gq0, gk1 = gq0;
    if (lane < 48) { gq0 = *(const f32x4*)(qn + lane * 8); gq1 = *(const f32x4*)(qn + lane * 8 + 4); }
    if (lane < 32) { gk0 = *(const f32x4*)(kvn + lane * 8); gk1 = *(const f32x4*)(kvn + lane * 8 + 4); }
#pragma unroll
    for (int x = 0; x < NR; ++x) {
        {   float f[8];
#pragma unroll
            for (int j = 0; j < 4; ++j) { f[2 * j] = bf_lo(vq[x][j]); f[2 * j + 1] = bf_hi(vq[x][j]); }
            float ss = 0.f;
#pragma unroll
            for (int j = 0; j < 8; ++j) ss += f[j] * f[j];
            const float rs = 1.0f / sqrtf(wave_sum(ss) * (1.0f / 384.0f) + EPS);
            if (lane < 48) { u32x4 w; w.x = pk2(f[0] * rs * gq0[0], f[1] * rs * gq0[1]); w.y = pk2(f[2] * rs * gq0[2], f[3] * rs * gq0[3]); w.z = pk2(f[4] * rs * gq1[0], f[5] * rs * gq1[1]); w.w = pk2(f[6] * rs * gq1[2], f[7] * rs * gq1[3]);
                *(u32x4*)(Prow[x] + PC_QLAT + lane * 8) = w; } }
        {   float f[8];
#pragma unroll
            for (int j = 0; j < 4; ++j) { f[2 * j] = bf_lo(vkv[x][j]); f[2 * j + 1] = bf_hi(vkv[x][j]); }
            float ss = 0.f;
#pragma unroll
            for (int j = 0; j < 8; ++j) ss += f[j] * f[j];
            const float rs = 1.0f / sqrtf(wave_sum(ss) * (1.0f / 256.0f) + EPS);
            if (lane < 32) { u32x4 w; w.x = pk2(f[0] * rs * gk0[0], f[1] * rs * gk0[1]); w.y = pk2(f[2] * rs * gk0[2], f[3] * rs * gk0[3]); w.z = pk2(f[4] * rs * gk1[0], f[5] * rs * gk1[1]); w.w = pk2(f[6] * rs * gk1[2], f[7] * rs * gk1[3]);
                *(u32x4*)(Prow[x] + PC_KVLAT + lane * 8) = w; } }
        if (lane < 16) { const float x1 = bf_lo(kr1[x]), x2 = bf_lo(kr2[x]); const float2 t = t16[x];
            const unsigned o = pk2(x1 * t.x - x2 * t.y, x1 * t.y + x2 * t.x);
            Prow[x][PC_KROPE + lane] = (bf16)(o & 0xffffu); Prow[x][PC_KROPE + 16 + lane] = (bf16)(o >> 16); }
    }
}

constexpr int MLA_KSTR = 208, MLA_VSTR = 192, MLA_KBUF = 64 * MLA_KSTR, MLA_VBUF = 64 * MLA_VSTR, MLA_V0 = 2 * MLA_KBUF;
DI void mla_unit(Frame& F, int b, int h, int qb, const bf16* Q, const bf16* KVH, const bf16* P, bf16* MIX) {
    const int tid = (F.wave * 64 + lane_id()), lane = tid & 63, w = F.wave, r = lane & 31, hh = lane >> 5;
    const int q0 = qb * 256, qw0 = q0 + 32 * w; const size_t tokb = (size_t)b * SEQ;
    bf16x8 qf[6];
    { const bf16* qp = Q + (tokb + qw0 + r) * 768 + h * 96 + 8 * hh;
#pragma unroll
      for (int st = 0; st < 6; ++st) qf[st] = *(const bf16x8*)(qp + 16 * st); }
    const bf16* ksrc = KVH + (tokb + (tid >> 3)) * 1024 + h * 128 + (tid & 7) * 8;
    const bf16* pesrc = P + (tokb + (tid >> 2)) * AB_P + PC_KROPE + (tid & 3) * 8;
    const bf16* vsrc = ksrc + 64;
    const int kdst = (tid >> 3) * MLA_KSTR + (tid & 7) * 16, pedst = (tid >> 2) * MLA_KSTR + 128 + (tid & 3) * 16, vdst = (tid >> 3) * MLA_VSTR + (tid & 7) * 16;
    const int nt = 4 * (qb + 1);
    u32x4 kreg, pereg = (u32x4){0u, 0u, 0u, 0u}, vreg;
    kreg = *(const u32x4*)ksrc; if (tid < 256) pereg = *(const u32x4*)pesrc; vreg = *(const u32x4*)vsrc;
    float m = -INFINITY, l = 0.f; f32x16 o[2]; o[0] = zero16(); o[1] = zero16();
    for (int t = 0; t < nt; ++t) {
        LAS unsigned char* Kb = F.lds + (t & 1) * MLA_KBUF; LAS unsigned char* Vb = F.lds + MLA_V0 + (t & 1) * MLA_VBUF;
        *(LAS u32x4*)(Kb + kdst) = kreg; if (tid < 256) *(LAS u32x4*)(Kb + pedst) = pereg; *(LAS u32x4*)(Vb + vdst) = vreg;
        __syncthreads();
        if (t + 1 < nt) { kreg = *(const u32x4*)(ksrc + (size_t)(t + 1) * 64 * 1024); if (tid < 256) pereg = *(const u32x4*)(pesrc + (size_t)(t + 1) * 64 * AB_P); vreg = *(const u32x4*)(vsrc + (size_t)(t + 1) * 64 * 1024); }
        if (64 * t <= qw0 + 31) {
            f32x16 p0, p1; qk_tile<6>(Kb, MLA_KSTR, qf, p0, p1, r, hh);
            if (64 * t + 63 > qw0) { const int qg = qw0 + r;
#pragma unroll
                for (int i = 0; i < 16; ++i) { const int kv = 64 * t + crow(i, hh); if (kv > qg) p0[i] = -INFINITY; if (kv + 32 > qg) p1[i] = -INFINITY; } }
            softmax_step<2>(p0, p1, m, l, o);
            pv_tile<2>(Vb, MLA_VSTR, p0, p1, o, lane);
        }
    }
    l += __shfl_xor(l, 32);
    store_o64(MIX + (tokb + qw0 + r) * 1536 + h * 64, o, 1.0f / l, hh);
}

constexpr int RT_KS = 0, RT_KT = 18432, RT_VT = 43008, RT_ST = 83968, RT_RED = 102400, RT_KRS = 192, RT_VS = 320;
DI void ret_unit(Frame& F, int b, int h, const bf16* P, const float* gn, bf16* MIX) {
    const int lane = (F.wave * 64 + lane_id()) & 63, w = F.wave, r = lane & 31, hh = lane >> 5;
    const int qg = w & 3, vh = w >> 2;
    const int dvb = w & 3, db2 = w >> 2;
    const size_t tokb = (size_t)b * SEQ;
    const float lg2 = log1pf(-ex2(-5.0f - (float)h)) * LOG2E;
    const float gam = ex2(lg2), g127 = ex2(127.0f * lg2), g128 = ex2(128.0f * lg2);
    LAS unsigned char* Ks = F.lds + RT_KS; LAS unsigned char* Kt = F.lds + RT_KT; LAS unsigned char* Vt = F.lds + RT_VT; LAS unsigned char* St = F.lds + RT_ST;
    LAS f32x2_t* red = (LAS f32x2_t*)(F.lds + RT_RED);
    f32x16 st = zero16();
    u32x4 kreg[2], vreg[4]; bf16x8 qf[4];
    const int tid = F.wave * 64 + lane;
#define FK_RET_LOAD(n_) do { const size_t tok0_ = tokb + (size_t)(n_) * 128; \
        _Pragma("unroll") for (int it = 0; it < 2; ++it) { const int c = tid + 512 * it; kreg[it] = *(const u32x4*)(P + (tok0_ + (c >> 3)) * AB_P + PC_RK + h * 64 + (c & 7) * 8); } \
        _Pragma("unroll") for (int it = 0; it < 4; ++it) { const int c = tid + 512 * it; vreg[it] = *(const u32x4*)(P + (tok0_ + (c >> 4)) * AB_P + PC_RV + h * 128 + (c & 15) * 8); } \
        const bf16* qp = P + (tok0_ + 32 * qg + r) * AB_P + PC_RQ + h * 64 + 8 * hh; _Pragma("unroll") for (int s4 = 0; s4 < 4; ++s4) qf[s4] = *(const bf16x8*)(qp + 16 * s4); } while (0)
    FK_RET_LOAD(0);
    for (int n = 0; n < 16; ++n) {
        const size_t tok0 = tokb + (size_t)n * 128;
        __syncthreads();
#pragma unroll
        for (int i = 0; i < 16; ++i) *(LAS unsigned short*)(St + (32 * dvb + crow(i, hh)) * 144 + (32 * db2 + r) * 2) = (unsigned short)(pk2(st[i] * gam, 0.f) & 0xffffu);
#pragma unroll
        for (int it = 0; it < 2; ++it) { const int c = tid + 512 * it; *(LAS u32x4*)(Ks + (c >> 3) * 144 + (c & 7) * 16) = kreg[it]; *(LAS u32x4*)(Kt + (c >> 3) * RT_KRS + (c & 7) * 16) = kreg[it]; }
#pragma unroll
        for (int it = 0; it < 4; ++it) { const int c = tid + 512 * it; *(LAS u32x4*)(Vt + (c >> 4) * RT_VS + (c & 15) * 16) = vreg[it]; }
        bf16x8 qc[4];
#pragma unroll
        for (int s4 = 0; s4 < 4; ++s4) qc[s4] = qf[s4];
        __syncthreads();
        if (n + 1 < 16) FK_RET_LOAD(n + 1);
        const size_t tok = tok0 + 32 * qg + r; const bf16* rgp = P + tok * AB_P + PC_RG + h * 128 + 64 * vh;
        u32x2 gv[2][4];
#pragma unroll
        for (int db = 0; db < 2; ++db)
#pragma unroll
            for (int g4 = 0; g4 < 4; ++g4) gv[db][g4] = *(const u32x2*)(rgp + 32 * db + 8 * g4 + 4 * hh);
        f32x16 o[2]; o[0] = zero16(); o[1] = zero16();
        const int ntile = (qg >> 1) + 1;
        for (int kt = 0; kt < ntile; ++kt) {
            f32x16 p0, p1; qk_tile<4>(Ks + kt * 64 * 144, 144, qc, p0, p1, r, hh);
            if (kt == (qg >> 1)) { const int ql = 32 * qg + r;
#pragma unroll
                for (int i = 0; i < 16; ++i) { const int kv = 64 * kt + crow(i, hh); if (kv > ql) p0[i] = 0.f; if (kv + 32 > ql) p1[i] = 0.f; } }
            pv_tile<2>(Vt + 64 * kt * RT_VS + 64 * vh * 2, RT_VS, p0, p1, o, lane);
        }
#pragma unroll
        for (int s4 = 0; s4 < 4; ++s4)
#pragma unroll
            for (int db = 0; db < 2; ++db) { const bf16x8 sf = *(const LAS bf16x8*)(St + (64 * vh + 32 * db + r) * 144 + (16 * s4 + 8 * hh) * 2); o[db] = MFMA32(sf, qc[s4], o[db]); }
        float s1 = 0.f, s2 = 0.f;
#pragma unroll
        for (int db = 0; db < 2; ++db)
#pragma unroll
            for (int i = 0; i < 16; ++i) { s1 += o[db][i]; s2 += o[db][i] * o[db][i]; }
        s1 += __shfl_xor(s1, 32); s2 += __shfl_xor(s2, 32);
        if (hh == 0) red[(32 * qg + r) * 2 + vh] = (f32x2_t){s1, s2};
        {
            f32x16 acc = zero16();
#pragma unroll
            for (int s8 = 0; s8 < 8; ++s8) { const bf16x8 vf = tr_frag(Vt + tr_lane_off(lane, RT_VS, 8) + 16 * s8 * RT_VS + 32 * dvb * 2, 4 * RT_VS);
                const bf16x8 kf = tr_frag(Kt + tr_lane_off(lane, RT_KRS, 8) + 16 * s8 * RT_KRS + 32 * db2 * 2, 4 * RT_KRS);
                acc = MFMA32(vf, kf, acc); }
            st = st * g128 + acc * g127;
        }
        __syncthreads();
        const f32x2_t ra = red[(32 * qg + r) * 2], rb = red[(32 * qg + r) * 2 + 1];
        const float mu = (ra.x + rb.x) * (1.0f / 128.0f); const float var = (ra.y + rb.y) * (1.0f / 128.0f) - mu * mu; const float rs = 1.0f / sqrtf(var + EPS);
        const float* gnp = gn + h * 128 + 64 * vh; bf16* op = MIX + tok * 1536 + 512 + h * 128 + 64 * vh;
#pragma unroll
        for (int db = 0; db < 2; ++db)
#pragma unroll
            for (int g4 = 0; g4 < 4; ++g4) { const int dv = 32 * db + 8 * g4 + 4 * hh; const u32x2 gvv = gv[db][g4]; const f32x4 gg = *(const f32x4*)(gnp + dv);
                const float g0 = bf_lo(gvv.x), g1 = bf_hi(gvv.x), g2 = bf_lo(gvv.y), g3 = bf_hi(gvv.y);
                u32x2 wv; wv.x = pk2(silu_f(g0) * ((o[db][4 * g4] - mu) * rs * gg[0]), silu_f(g1) * ((o[db][4 * g4 + 1] - mu) * rs * gg[1]));
                wv.y = pk2(silu_f(g2) * ((o[db][4 * g4 + 2] - mu) * rs * gg[2]), silu_f(g3) * ((o[db][4 * g4 + 3] - mu) * rs * gg[3]));
                *(u32x2*)(op + dv) = wv; }
    }
#undef FK_RET_LOAD
}

constexpr int SW_KS = 0, SW_VT = 36864, SW_VSTR = 192;
DI void swa_unit(Frame& F, int b, int hkv, int blk, const bf16* P2, const float* sinks, bf16* MIX2) {
    const int tid = (F.wave * 64 + lane_id()), lane = tid & 63, w = F.wave, r = lane & 31, hh = lane >> 5; const size_t tokb = (size_t)b * SEQ;
    const int kb0 = 128 * (blk - 1);
    LAS unsigned char* Ks = F.lds + SW_KS; LAS unsigned char* Vt = F.lds + SW_VT;
#pragma unroll
    for (int it = 0; it < 4; ++it) { const int c = tid + 512 * it, row = c >> 3, part = c & 7; const int key = kb0 + row;
        u32x4 v = (u32x4){0u, 0u, 0u, 0u}; if (key >= 0) v = *(const u32x4*)(P2 + (tokb + key) * CD_IN + P2_SK + hkv * 64 + part * 8);
        *(LAS u32x4*)(Ks + row * 144 + part * 16) = v; }
#pragma unroll
    for (int it = 0; it < 4; ++it) { const int c = tid + 512 * it, row = c >> 3, part = c & 7; const int key = kb0 + row;
        u32x4 v = (u32x4){0u, 0u, 0u, 0u}; if (key >= 0) v = *(const u32x4*)(P2 + (tokb + key) * CD_IN + P2_SV + hkv * 64 + part * 8);
        *(LAS u32x4*)(Vt + row * SW_VSTR + part * 16) = v; }
    __syncthreads();
    const int hq = hkv * 8 + w; const float slope2 = ex2(-8.0f * (float)(hq + 1) / 16.0f) * LOG2E, sink2 = sinks[hq] * LOG2E;
    bf16x8 qn[4];
    { const bf16* qp = P2 + (tokb + 128 * blk + r) * CD_IN + P2_SQ + hq * 64 + 8 * hh;
#pragma unroll
      for (int s4 = 0; s4 < 4; ++s4) qn[s4] = *(const bf16x8*)(qp + 16 * s4); }
    for (int j = 0; j < 4; ++j) {
        const int qrow = 128 * blk + 32 * j + r; const int qband = 128 + 32 * j + r;
        bf16x8 qf[4];
#pragma unroll
        for (int s4 = 0; s4 < 4; ++s4) qf[s4] = qn[s4];
        if (j < 3) { const bf16* qp = P2 + (tokb + qrow + 32) * CD_IN + P2_SQ + hq * 64 + 8 * hh;
#pragma unroll
            for (int s4 = 0; s4 < 4; ++s4) qn[s4] = *(const bf16x8*)(qp + 16 * s4); }
        float m = sink2, l = (hh == 0) ? 1.0f : 0.0f; f32x16 o[2]; o[0] = zero16(); o[1] = zero16();
        const int bt_lo = (32 * j + 1) >> 6, bt_hi = (32 * j + 159) >> 6;
        for (int bt = bt_lo; bt <= bt_hi; ++bt) {
            f32x16 p0, p1; qk_tile<4>(Ks + bt * 64 * 144, 144, qf, p0, p1, r, hh);
#pragma unroll
            for (int i = 0; i < 16; ++i) { const int k0 = 64 * bt + crow(i, hh), k1 = k0 + 32; const int d0 = qband - k0, d1 = qband - k1;
                p0[i] = (d0 >= 0 && d0 < 128 && kb0 + k0 >= 0) ? p0[i] - slope2 * (float)d0 : -INFINITY;
                p1[i] = (d1 >= 0 && d1 < 128 && kb0 + k1 >= 0) ? p1[i] - slope2 * (float)d1 : -INFINITY; }
            softmax_step<2>(p0, p1, m, l, o);
            pv_tile<2>(Vt + 64 * bt * SW_VSTR, SW_VSTR, p0, p1, o, lane);
        }
        l += __shfl_xor(l, 32);
        store_o64(MIX2 + (tokb + qrow) * 1536 + hq * 64, o, 1.0f / l, hh);
    }
}

constexpr int SB_K0 = 0, SB_V0 = 18432, SB_FLAG = 43008, SB_BUF = 9216, SB_VBUF = 12288, SB_VSTR = 192;
constexpr float SB_EXIT = 110.0f;
DI float softplus_f(float z) { return fmaxf(z, 0.f) + 0.6931471805599453f * __builtin_amdgcn_logf(1.0f + ex2(-fabsf(z) * LOG2E)); }
DI void sb_unit(Frame& F, int b, int h, int qb, const bf16* P2, bf16* MIX2) {
    const int tid = (F.wave * 64 + lane_id()), lane = tid & 63, w = F.wave, r = lane & 31, hh = lane >> 5; const size_t tokb = (size_t)b * SEQ;
    const int q0 = qb * 256, qw0 = q0 + 32 * w, qg = qw0 + r;
    bf16x8 qf[4];
    { const bf16* qp = P2 + (tokb + qg) * CD_IN + P2_BQ + h * 64 + 8 * hh;
#pragma unroll
      for (int s4 = 0; s4 < 4; ++s4) qf[s4] = *(const bf16x8*)(qp + 16 * s4); }
    const bf16* ksrc = P2 + (tokb + (tid >> 3)) * CD_IN + P2_BK + h * 64 + (tid & 7) * 8;
    const bf16* vsrc = P2 + (tokb + (tid >> 3)) * CD_IN + P2_BV + h * 64 + (tid & 7) * 8;
    const int kdst = (tid >> 3) * 144 + (tid & 7) * 16, vdst = (tid >> 3) * SB_VSTR + (tid & 7) * 16;
    LAS unsigned* flags = (LAS unsigned*)(F.lds + SB_FLAG);
    const int tmax = 4 * qb + 3;
    u32x4 kreg = *(const u32x4*)(ksrc + (size_t)tmax * 64 * CD_IN), vreg = *(const u32x4*)(vsrc + (size_t)tmax * 64 * CD_IN);
    float run = 0.f; bool wdone = false; f32x16 o[2]; o[0] = zero16(); o[1] = zero16();
    int it = 0;
    for (int t = tmax; t >= 0; --t, ++it) {
        LAS unsigned char* Kb = F.lds + SB_K0 + (it & 1) * SB_BUF; LAS unsigned char* Vb = F.lds + SB_V0 + (it & 1) * SB_VBUF;
        *(LAS u32x4*)(Kb + kdst) = kreg; *(LAS u32x4*)(Vb + vdst) = vreg;
        if (lane == 0) flags[(it & 1) * 8 + w] = wdone ? 1u : 0u;
        __syncthreads();
        unsigned alld = 1u;
#pragma unroll
        for (int x = 0; x < 8; ++x) alld &= flags[(it & 1) * 8 + x];
        if (alld) break;
        if (t > 0) { kreg = *(const u32x4*)(ksrc + (size_t)(t - 1) * 64 * CD_IN); vreg = *(const u32x4*)(vsrc + (size_t)(t - 1) * 64 * CD_IN); }
        if (64 * t <= qw0 + 30 && !wdone) {
            f32x16 z0, z1; qk_tile<4>(Kb, 144, qf, z0, z1, r, hh);
            f32x16 s0, s1v; float gs[8];
#pragma unroll
            for (int i = 0; i < 16; ++i) { const int kv = 64 * t + crow(i, hh); s0[i] = (kv < qg) ? softplus_f(z0[i]) : 0.f; s1v[i] = (kv + 32 < qg) ? softplus_f(z1[i]) : 0.f; }
#pragma unroll
            for (int g4 = 0; g4 < 4; ++g4) { gs[g4] = (s0[4 * g4] + s0[4 * g4 + 1]) + (s0[4 * g4 + 2] + s0[4 * g4 + 3]); gs[4 + g4] = (s1v[4 * g4] + s1v[4 * g4 + 1]) + (s1v[4 * g4 + 2] + s1v[4 * g4 + 3]); }
            float above[8]; float accs = 0.f;
#pragma unroll
            for (int gi = 7; gi >= 0; --gi) { const float oth = __shfl_xor(gs[gi], 32); above[gi] = accs + (hh == 0 ? oth : 0.f); accs += gs[gi] + oth; }
#pragma unroll
            for (int g4 = 0; g4 < 4; ++g4) {
                { float c = run + above[g4];
#pragma unroll
                  for (int e = 3; e >= 0; --e) { const int i = 4 * g4 + e; c += s0[i]; const int kv = 64 * t + crow(i, hh); z0[i] = (kv < qg) ? ex2((z0[i] - c) * LOG2E) : 0.f; } }
                { float c = run + above[4 + g4];
#pragma unroll
                  for (int e = 3; e >= 0; --e) { const int i = 4 * g4 + e; c += s1v[i]; const int kv = 64 * t + 32 + crow(i, hh); z1[i] = (kv < qg) ? ex2((z1[i] - c) * LOG2E) : 0.f; } }
            }
            pv_tile<2>(Vb, SB_VSTR, z0, z1, o, lane);
            run += accs;
            wdone = __all(run > SB_EXIT);
        }
    }
    store_o64(MIX2 + (tokb + qg) * 1536 + 1024 + h * 64, o, 1.0f, hh);
}
}
namespace fk {
enum InIdx { I_X = 0, I_AB_NORM, I_AB_W_IN, I_Q_NORM, I_W_UQ, I_KV_NORM, I_W_UKV, I_RET_GN, I_AB_W_OUT, I_FFN_NORM, I_FFN_WG, I_FFN_WU, I_FFN_WD,
             I_CD_NORM, I_CD_W_IN, I_SINKS, I_CD_W_OUT, I_MOE_NORM, I_ROUTER, I_MOE_WG, I_MOE_WU, I_MOE_WD, I_FINAL_NORM };

DI void prologue_phase(Frame& F, const Args& A) {
    const int tid = (F.wave * 64 + lane_id()), lane = tid & 63;
    const int gt = F.bid * NTHR + tid, NGT = F.G * NTHR;
    float2* cs16 = (float2*)(F.ws + WS_CS16); float2* cs32 = (float2*)(F.ws + WS_CS32);
    for (int e = gt; e < SEQ * 48; e += NGT) {
        float sn, cs;
        if (e < SEQ * 16) { const int pos = e >> 4, i = e & 15; rope_cs(pos, i, 16, sn, cs); cs16[e] = make_float2(cs, sn); }
        else { const int e2 = e - SEQ * 16; const int pos = e2 >> 5, i = e2 & 31; rope_cs(pos, i, 32, sn, cs); cs32[e2] = make_float2(cs, sn); }
    }
    {
        const float* W = A.in[I_W_UQ]; bf16* WT = (bf16*)(F.ws + WS_W_UQ); const float sc = 0.10206207261596575f * LOG2E;
        for (int e = gt; e < 768 * 384; e += NGT) { const int n = e / 384, k = e - n * 384; int src;
            if (n < 512) src = (n >> 6) * 96 + (n & 63); else if (n < 640) { const int c = n - 512; src = (c >> 4) * 96 + 64 + (c & 15); } else { const int c = n - 640; src = (c >> 4) * 96 + 80 + (c & 15); }
            WT[e] = (bf16)(pk2(W[(size_t)k * 768 + src] * sc, 0.f) & 0xffffu); }
    }
    LAS float* scr = (LAS float*)(F.lds + F.wave * 16384);
    const int gw = F.bid * NWAVES + F.wave, NGW = F.G * NWAVES;
    constexpr int N_ABIN = 16 * 117, N_ABPAD = 16 * 3, N_UKV = 4 * 32;
    constexpr int NITEMS = N_ABIN + N_ABPAD + N_UKV;
    for (int it = gw; it < NITEMS; it += NGW) {
        int q = it;
        if (q < N_ABIN) { conv_matrix_item(A.in[I_AB_W_IN], 1024, AB_IN, (bf16*)(F.ws + WS_W_ABIN), 1, scr, q, lane); continue; } q -= N_ABIN;
        if (q < N_ABPAD) { conv_item(A.in[I_AB_W_IN], AB_IN, (bf16*)(F.ws + WS_W_ABIN), 1024, 672 + 32 * (q % 3), -1, 64 * (q / 3), 1.f, scr, lane); continue; } q -= N_ABPAD;
        conv_matrix_item(A.in[I_W_UKV], 256, 1024, (bf16*)(F.ws + WS_W_UKV), 0, scr, q, lane);
    }
    for (int m = gw; m < T; m += 2 * NGW) { const int m2 = m + NGW; const int s0 = A.pad ? ((m & ~(SEQ - 1)) | (SEQ - 1 - (m & (SEQ - 1)))) : m, s1 = A.pad ? ((m2 & ~(SEQ - 1)) | (SEQ - 1 - (m2 & (SEQ - 1)))) : m2;
        rms_rows2_to_bf16(A.in[I_X] + (size_t)s0 * DM, A.in[I_X] + (size_t)s1 * DM, A.in[I_AB_NORM], (bf16*)(F.ws + WS_XN) + (size_t)m * DM, (bf16*)(F.ws + WS_XN) + (size_t)(m + NGW) * DM, lane, A.pad ? -1.0f : 1.0f); }
}
constexpr int LC_ABOUT = 24 * 32, LC_FG = 16 * 112, LC_FD = 56 * 32, LC_CDIN = 16 * 88, LC_CDOUT = 24 * 32, LC_ITEMS = LC_ABOUT + 2 * LC_FG + LC_FD + LC_CDIN + LC_CDOUT, LC_BATCH = 32;
DI void late_conv_item(Frame& F, const Args& A, int q, LAS float* scr, int lane) {
    if (q < LC_ABOUT) { conv_matrix_item(A.in[I_AB_W_OUT], 1536, 1024, (bf16*)(F.ws + WS_W_ABOUT), 0, scr, q, lane); return; } q -= LC_ABOUT;
    if (q < LC_FG) { conv_matrix_item(A.in[I_FFN_WG], 1024, FF, (bf16*)(F.ws + WS_W_FGU), 2, scr, q, lane, A.in[I_FFN_NORM]); return; } q -= LC_FG;
    if (q < LC_FG) { conv_matrix_item(A.in[I_FFN_WU], 1024, FF, (bf16*)(F.ws + WS_W_FGU), 3, scr, q, lane, A.in[I_FFN_NORM]); return; } q -= LC_FG;
#if FFN_DOWN_FP8
    if (q < LC_FD) { conv_matrix_item8(A.in[I_FFN_WD], FF, 1024, F.ws + WS_W_FD, 0, W8_SCALE, scr, q, lane); return; } q -= LC_FD;
#else
    if (q < LC_FD) { conv_matrix_item(A.in[I_FFN_WD], FF, 1024, (bf16*)(F.ws + WS_W_FD), 0, scr, q, lane); return; } q -= LC_FD;
#endif
    if (q < LC_CDIN) { conv_matrix_item(A.in[I_CD_W_IN], 1024, CD_IN, (bf16*)(F.ws + WS_W_CDIN), 4, scr, q, lane, A.in[I_CD_NORM]); return; } q -= LC_CDIN;
    conv_matrix_item(A.in[I_CD_W_OUT], 1536, 1024, (bf16*)(F.ws + WS_W_CDOUT), 0, scr, q, lane);
}
DI void late_conv_drain(Frame& F, const Args& A) {
    const int lane = (F.wave * 64 + lane_id()) & 63; LAS float* scr = (LAS float*)(F.lds + F.wave * 16384);
    constexpr int NB = (LC_ITEMS + LC_BATCH - 1) / LC_BATCH;
    for (int bt = queue_first(F, 2); bt < NB; bt = queue_first(F, 2)) {
#pragma unroll 1
        for (int j = 0; j < LC_BATCH / NWAVES; ++j) { const int q = bt * LC_BATCH + j * NWAVES + F.wave; if (q < LC_ITEMS) late_conv_item(F, A, q, scr, lane); }
    }
}
DI void moe_conv_phase(Frame& F, const Args& A) {
    const int lane = (F.wave * 64 + lane_id()) & 63;
    LAS float* scr = (LAS float*)(F.lds + F.wave * 16384);
    const int gw = F.bid * NWAVES + F.wave, NGW = F.G * NWAVES;
    constexpr int N_G = 16 * 112, N_D = 56 * 32, PER = 2 * N_G + N_D;
    for (int it = gw; it < NEXP * PER; it += NGW) { const int e = it / PER; int q = it - e * PER;
        if (q < N_G) { conv_matrix_item8(A.in[I_MOE_WG] + (size_t)e * 1024 * FF, 1024, FF, F.ws + WS_MOEW_GU + (size_t)e * 7168 * 1024, 2, W8_SCALE, scr, q, lane); continue; } q -= N_G;
        if (q < N_G) { conv_matrix_item8(A.in[I_MOE_WU] + (size_t)e * 1024 * FF, 1024, FF, F.ws + WS_MOEW_GU + (size_t)e * 7168 * 1024, 3, W8_SCALE, scr, q, lane); continue; } q -= N_G;
        conv_matrix_item8(A.in[I_MOE_WD] + (size_t)e * FF * 1024, FF, 1024, F.ws + WS_MOEW_D + (size_t)e * 1024 * FF, 0, W8_SCALE, scr, q, lane);
    }
}
DI void norm8_phase(Frame& F, const float* g, unsigned char* XN8) {
    const int lane = (F.wave * 64 + lane_id()) & 63;
    const int gw = F.bid * NWAVES + F.wave, NGW = F.G * NWAVES;
    for (int m = gw; m < T; m += NGW) rms_row_to_fp8(F.out + (size_t)m * DM, g, XN8 + (size_t)m * DM, lane);
}
DI void norm_phase(Frame& F, const float* g, bf16* XN) {
    const int lane = (F.wave * 64 + lane_id()) & 63;
    const int gw = F.bid * NWAVES + F.wave, NGW = F.G * NWAVES;
    for (int m = gw; m < T; m += NGW) rms_row_to_bf16(F.out + (size_t)m * DM, g, XN + (size_t)m * DM, lane);
}
DI void ppost_phase(Frame& F, const Args& A) {
    const int lane = (F.wave * 64 + lane_id()) & 63;
    const int gw = F.bid * NWAVES + F.wave, NGW = F.G * NWAVES; bf16* P = (bf16*)(F.ws + WS_P);
    for (int m = gw; m < T; m += 4 * NGW) {
        bf16* const rows[4] = {P + (size_t)m * AB_P, P + (size_t)(m + NGW) * AB_P, P + (size_t)(m + 2 * NGW) * AB_P, P + (size_t)(m + 3 * NGW) * AB_P};
        const int pos[4] = {m & (SEQ - 1), (m + NGW) & (SEQ - 1), (m + 2 * NGW) & (SEQ - 1), (m + 3 * NGW) & (SEQ - 1)};
        p_post_rows<4>(rows, pos, A.in[I_Q_NORM], A.in[I_KV_NORM], (const float2*)(F.ws + WS_CS16), lane);
    }
}
constexpr int RL_TE = 36864, RL_TG = 37888, RL_RANK = 38912, RL_CNT = 39936, RL_BASE = 39968;
DI void route_phase_a(Frame& F, const Args& A) {
    const int tid = (F.wave * 64 + lane_id()), lane = tid & 63;
    LAS float* rt = (LAS float*)F.lds; LAS int* te = (LAS int*)(F.lds + RL_TE); LAS float* tg = (LAS float*)(F.lds + RL_TG); LAS int* trank = (LAS int*)(F.lds + RL_RANK);
    LAS unsigned* lcnt = (LAS unsigned*)(F.lds + RL_CNT); LAS unsigned* lbase = (LAS unsigned*)(F.lds + RL_BASE);
    for (int i = tid; i < 8192; i += NTHR) rt[(i >> 5) * 36 + (i & 31)] = A.in[I_ROUTER][i];
    if (tid < 8) lcnt[tid] = 0u;
    __syncthreads();
    const float* g = A.in[I_MOE_NORM]; unsigned char* XN3 = F.ws + WS_XN3;
    const GAS f32x4* gr = (const GAS f32x4*)g + lane;
    for (int q = 0; q < 4; ++q) {
        const int tl0 = F.wave * 16 + q * 4; const size_t tok0 = (size_t)F.bid * 128 + tl0;
        f32x4 v[4][4]; float rs[4];
#pragma unroll
        for (int t4 = 0; t4 < 4; ++t4) { const GAS u32x2* xr = (const GAS u32x2*)((const bf16*)(F.ws + WS_XN) + (tok0 + t4) * DM) + lane;
#pragma unroll
            for (int j = 0; j < 4; ++j) { const u32x2 hb = xr[64 * j]; v[t4][j] = (f32x4){bf_lo(hb.x), bf_hi(hb.x), bf_lo(hb.y), bf_hi(hb.y)}; } }
#pragma unroll
        for (int t4 = 0; t4 < 4; ++t4) { float s = 0.f;
#pragma unroll
            for (int j = 0; j < 4; ++j) s += (v[t4][j].x * v[t4][j].x + v[t4][j].y * v[t4][j].y) + (v[t4][j].z * v[t4][j].z + v[t4][j].w * v[t4][j].w);
            rs[t4] = 1.0f / sqrtf(wave_sum(s) * (1.f / DM) + EPS); }
        float lg[32];
#pragma unroll
        for (int i = 0; i < 32; ++i) lg[i] = 0.f;
#pragma unroll
        for (int j = 0; j < 4; ++j) { const f32x4 gg = gr[64 * j];
#pragma unroll
            for (int t4 = 0; t4 < 4; ++t4) { v[t4][j] = (f32x4){v[t4][j].x * rs[t4] * gg.x, v[t4][j].y * rs[t4] * gg.y, v[t4][j].z * rs[t4] * gg.z, v[t4][j].w * rs[t4] * gg.w};
                ((GAS unsigned*)(XN3 + (tok0 + t4) * DM) + lane)[64 * j] = pk4_fp8(v[t4][j].x, v[t4][j].y, v[t4][j].z, v[t4][j].w); }
            const int k0 = (64 * j + lane) * 4;
#pragma unroll
            for (int c = 0; c < 4; ++c) { const f32x4 r0 = *(const LAS f32x4*)(rt + (k0 >> 2) * 36 + c * 8), r1 = *(const LAS f32x4*)(rt + (k0 >> 2) * 36 + c * 8 + 4);
#pragma unroll
                for (int t4 = 0; t4 < 4; ++t4) { const float xv = v[t4][j][c];
                    lg[t4 * 8 + 0] += xv * r0[0]; lg[t4 * 8 + 1] += xv * r0[1]; lg[t4 * 8 + 2] += xv * r0[2]; lg[t4 * 8 + 3] += xv * r0[3];
                    lg[t4 * 8 + 4] += xv * r1[0]; lg[t4 * 8 + 5] += xv * r1[1]; lg[t4 * 8 + 6] += xv * r1[2]; lg[t4 * 8 + 7] += xv * r1[3]; } } }
        {
            const bool b5 = (lane & 32) != 0;
#pragma unroll
            for (int i = 0; i < 16; ++i) { const float send = b5 ? lg[i] : lg[16 + i]; const float keep = b5 ? lg[16 + i] : lg[i]; lg[i] = keep + __shfl_xor(send, 32); }
            const bool b4 = (lane & 16) != 0;
#pragma unroll
            for (int i = 0; i < 8; ++i) { const float send = b4 ? lg[i] : lg[8 + i]; const float keep = b4 ? lg[8 + i] : lg[i]; lg[i] = keep + __shfl_xor(send, 16); }
            const bool b3 = (lane & 8) != 0;
#pragma unroll
            for (int i = 0; i < 4; ++i) { const float send = b3 ? lg[i] : lg[4 + i]; const float keep = b3 ? lg[4 + i] : lg[i]; lg[i] = keep + __shfl_xor(send, 8); }
            const bool b2 = (lane & 4) != 0;
#pragma unroll
            for (int i = 0; i < 2; ++i) { const float send = b2 ? lg[i] : lg[2 + i]; const float keep = b2 ? lg[2 + i] : lg[i]; lg[i] = keep + __shfl_xor(send, 4); }
            const bool b1 = (lane & 2) != 0;
            { const float send = b1 ? lg[0] : lg[1]; const float keep = b1 ? lg[1] : lg[0]; lg[0] = keep + __shfl_xor(send, 2); }
            lg[0] += __shfl_xor(lg[0], 1);
        }
        float l8[8];
#pragma unroll
        for (int e = 0; e < 8; ++e) l8[e] = __shfl(lg[0], (lane & 48) + 2 * e);
        if ((lane & 15) == 0) {
            const int tl = tl0 + (lane >> 4);
            int e0 = 0; float b0 = l8[0];
#pragma unroll
            for (int e = 1; e < 8; ++e) if (l8[e] > b0) { b0 = l8[e]; e0 = e; }
            int e1 = 0; float b1v = -INFINITY;
#pragma unroll
            for (int e = 0; e < 8; ++e) if (e != e0 && l8[e] > b1v) { b1v = l8[e]; e1 = e; }
            const float p1 = __expf(b1v - b0); const float g0 = 1.0f / (1.0f + p1), g1 = p1 / (1.0f + p1);
            te[tl * 2] = e0; te[tl * 2 + 1] = e1; tg[tl * 2] = g0; tg[tl * 2 + 1] = g1;
            trank[tl * 2] = (int)__hip_atomic_fetch_add(lcnt + e0, 1u, __ATOMIC_RELAXED, __HIP_MEMORY_SCOPE_WORKGROUP);
            trank[tl * 2 + 1] = (int)__hip_atomic_fetch_add(lcnt + e1, 1u, __ATOMIC_RELAXED, __HIP_MEMORY_SCOPE_WORKGROUP);
        }
    }
    __syncthreads();
    if (tid < 8) lbase[tid] = __hip_atomic_fetch_add(F.ctl + CW_ECNT + 64 * tid, lcnt[tid], RLX_AGENT);
}
struct MoeGeom { int pend[8]; int npanels; };
DI MoeGeom moe_geom(Frame& F) {
    MoeGeom mg; int acc = 0;
#pragma unroll
    for (int e = 0; e < 8; ++e) { const unsigned c = __hip_atomic_load(F.ctl + CW_ECNT + 64 * e, RLX_AGENT); acc += (int)((c + 255u) >> 8); mg.pend[e] = acc; }
    mg.npanels = acc; return mg;
}
DI void route_phase_b(Frame& F, const MoeGeom& mg) {
    const int tid = (F.wave * 64 + lane_id());
    LAS int* te = (LAS int*)(F.lds + RL_TE); LAS float* tg = (LAS float*)(F.lds + RL_TG); LAS int* trank = (LAS int*)(F.lds + RL_RANK); LAS unsigned* lbase = (LAS unsigned*)(F.lds + RL_BASE);
    gu32* slot_tok = F.ctl + CW_SLOT_TOK; GAS float* slot_gate = (GAS float*)(F.ctl + CW_SLOT_GATE);
    for (int idx = tid; idx < 256; idx += NTHR) { const int e = te[idx]; int pstart = 0;
#pragma unroll
        for (int x = 0; x < 7; ++x) if (e > x) pstart = mg.pend[x];
        const int slot = pstart * 256 + (int)lbase[e] + trank[idx];
        const unsigned tk = (unsigned)(F.bid * 128 + (idx >> 1)) * 2u + (unsigned)(idx & 1);
        slot_tok[slot] = tk + 1u; slot_gate[slot] = tg[idx]; }
}
template <int NTILE, bool GATHERED> struct MoeOrder {
    int cp0, cpn, G, c; const volatile LAS unsigned char* pe;
    DI bool next(int i, Unit& u) const {
        const unsigned L = (unsigned)i * (unsigned)G + (unsigned)c; if (L >= (unsigned)(cpn * NTILE)) return false;
        const unsigned pn = L / (unsigned)cpn, pl = L - pn * (unsigned)cpn; const int panel = cp0 + (int)pl; const int e = __builtin_amdgcn_readfirstlane((int)pe[panel]);
        u.pm = GATHERED ? panel : (int)pl; u.pn = e * NTILE + (int)pn; u.om = (int)pl; u.on = (int)pn; u.ex = e; return true;
    }
};
DI void final_phase(Frame& F, const Args& A) {
    const int lane = (F.wave * 64 + lane_id()) & 63;
    const int gw = F.bid * NWAVES + F.wave, NGW = F.G * NWAVES; const float* g = A.in[I_FINAL_NORM];
    const bf16* H = (const bf16*)(F.ws + WS_XN); const bf16* Y0 = (const bf16*)(F.ws + WS_Y0); const bf16* Y1 = (const bf16*)(F.ws + WS_Y1);
    for (int m = gw; m < T; m += NGW) {
        GAS f32x4* xr = (GAS f32x4*)(F.out + (size_t)m * DM) + lane; const GAS u32x2* hr = (const GAS u32x2*)(H + (size_t)m * DM) + lane;
        const GAS u32x2* y0 = (const GAS u32x2*)(Y0 + (size_t)m * DM) + lane; const GAS u32x2* y1 = (const GAS u32x2*)(Y1 + (size_t)m * DM) + lane; const GAS f32x4* gr = (const GAS f32x4*)g + lane;
        f32x4 v[4]; float s = 0.f;
#pragma unroll
        for (int j = 0; j < 4; ++j) { const u32x2 hb = __builtin_nontemporal_load((const u32x2*)(hr + 64 * j)), a = __builtin_nontemporal_load((const u32x2*)(y0 + 64 * j)), b = __builtin_nontemporal_load((const u32x2*)(y1 + 64 * j));
            v[j].x = bf_lo(hb.x) + bf_lo(a.x) + bf_lo(b.x); v[j].y = bf_hi(hb.x) + bf_hi(a.x) + bf_hi(b.x); v[j].z = bf_lo(hb.y) + bf_lo(a.y) + bf_lo(b.y); v[j].w = bf_hi(hb.y) + bf_hi(a.y) + bf_hi(b.y);
            s += (v[j].x * v[j].x + v[j].y * v[j].y) + (v[j].z * v[j].z + v[j].w * v[j].w); }
        const float rs = 1.0f / sqrtf(wave_sum(s) * (1.f / DM) + EPS);
#pragma unroll
        for (int j = 0; j < 4; ++j) { const f32x4 gg = gr[64 * j]; __builtin_nontemporal_store((f32x4){v[j].x * rs * gg.x, v[j].y * rs * gg.y, v[j].z * rs * gg.z, v[j].w * rs * gg.w}, (f32x4*)(xr + 64 * j)); }
    }
}

constexpr int N_PHASES = 16;
__global__ void __launch_bounds__(NTHR, 2) mega_fwd(Args args) {
    extern __shared__ __attribute__((aligned(16))) unsigned char lds_raw[];
    Frame F;
    F.lds = (LAS unsigned char*)lds_raw; F.MISC = (volatile LAS unsigned*)(F.lds + MISC_OFF);
    F.wave = __builtin_amdgcn_readfirstlane((int)threadIdx.x >> 6); F.G = gridDim.x; F.bid = blockIdx.x;
    F.ws = args.ws; F.ctl = (gu32*)(args.ws + WS_CTL); F.out = args.out;
    const Args& A = args;
    if ((F.wave * 64 + lane_id()) < 32) F.MISC[(F.wave * 64 + lane_id())] = 0u;
    __syncthreads();
    XcdBarrier bar = xcd_barrier_post((unsigned*)(F.ctl + CW_BAR) + args.li * XCD_BAR_WORDS, F.MISC + 8);
    const int lo = args.ph_lo, hi = args.ph_hi;
#define IN(k) (lo <= (k) && (k) < hi)
#ifdef PROBE_MASK
    volatile LAS unsigned long long* tsv = (volatile LAS unsigned long long*)(F.lds + MISC_OFF + 256);
#define TSTAMP(i) do { if (F.bid == 0 && (F.wave * 64 + lane_id()) == 0) tsv[i] = __builtin_amdgcn_s_memrealtime(); } while (0)
#define TACC(i, a, b) do { if (F.bid == 0 && (F.wave * 64 + lane_id()) == 0) tsv[i] += tsv[b] - tsv[a]; } while (0)
    if (F.bid == 0 && (F.wave * 64 + lane_id()) == 0) { tsv[30] = 0ull; tsv[31] = 0ull; tsv[23] = 0ull; tsv[24] = 0ull; tsv[25] = 0ull; }
#ifndef PROBE_EPI_PHASE
#define PROBE_EPI_PHASE 99
#endif
#define EPI_ON(k) do { if (F.bid == 0 && (F.wave * 64 + lane_id()) == 0) tsv[23] = ((k) == PROBE_EPI_PHASE) ? 1ull : 0ull; } while (0)
#else
#define TSTAMP(i) do {} while (0)
#define TACC(i, a, b) do {} while (0)
#define EPI_ON(k) do {} while (0)
#endif
#ifdef PROBE_MASK
#define UNIT_T0(cond) unsigned long long _ut0 = 0ull; if (cond) _ut0 = __builtin_amdgcn_s_memrealtime();
#define UNIT_T1(cond, slot) if (cond) { const unsigned long long _ut1 = __builtin_amdgcn_s_memrealtime(); if ((F.wave * 64 + lane_id()) == 0) __hip_atomic_store(F.ctl + CW_PROBE + (slot), (unsigned)(_ut1 - _ut0), RLX_AGENT); }
#else
#define UNIT_T0(cond)
#define UNIT_T1(cond, slot)
#endif
#define SEAM(k) do { if (IN(k) && IN((k) + 1)) xcd_barrier(bar); TSTAMP((k) + 1); } while (0)
    TSTAMP(0);
    unsigned char* ws = F.ws;
    float* SSQ = (float*)(ws + WS_SSQ);
    bf16* XN = (bf16*)(ws + WS_XN); bf16* P = (bf16*)(ws + WS_P); bf16* Qb = (bf16*)(ws + WS_Q); bf16* KVH = (bf16*)(ws + WS_KVH); bf16* MIX = (bf16*)(ws + WS_MIXED);
    bf16* HACT = (bf16*)(ws + WS_HACT); bf16* P2 = (bf16*)(ws + WS_P2); bf16* MIX2 = (bf16*)(ws + WS_MIXED2); unsigned char* MACT = ws + WS_MACT; unsigned char* XN3 = ws + WS_XN3; bf16* Y0 = (bf16*)(ws + WS_Y0); bf16* Y1 = (bf16*)(ws + WS_Y1);

    if (IN(0)) prologue_phase(F, A);
    SEAM(0);
    EPI_ON(1);
    if (IN(1)) { Gemm g{XN, (const bf16*)(ws + WS_W_ABIN), 1024, 1024, 1024, nullptr}; pg8::StaticOrder S; S.init(T, AB_P, F.G, F.bid); EpiP E{P, (const float2*)(ws + WS_CS32)};
        pg8::gemm_phase<EpiP, pg8::StaticOrder, false>(F.lds, g, S, E, F.wave);
        late_conv_drain(F, A); }
    SEAM(1);
    if (IN(2)) ppost_phase(F, A);
    SEAM(2);
    EPI_ON(3);
    if (IN(3)) {
        { Gemm g{P + PC_QLAT, (const bf16*)(ws + WS_W_UQ), AB_P, 384, 384, nullptr}; pg8::StaticOrder S; S.init(T, 768, F.G, F.bid); EpiQ E{Qb, (const float2*)(ws + WS_CS16)};
          pg8::gemm_phase<EpiQ, pg8::StaticOrder, false>(F.lds, g, S, E, F.wave); }
        { Gemm g{P + PC_KVLAT, (const bf16*)(ws + WS_W_UKV), AB_P, 256, 256, nullptr}; pg8::StaticOrder S; S.init(T, 1024, F.G, F.bid); EpiBf16 E{KVH, 1024, nullptr, F.lds};
          pg8::gemm_phase<EpiBf16, pg8::StaticOrder, false>(F.lds, g, S, E, F.wave); }
    }
    SEAM(3);
    if (IN(4)) {
        for (int it = queue_first(F, 0); it < 128 + 1024; ) { const unsigned nxq = queue_post(F, 0);
            UNIT_T0(it == 0 || it == 128 || it == 128 + 1023)
            if (it < 128) ret_unit(F, it >> 3, it & 7, P, A.in[I_RET_GN], MIX);
            else { const int j = it - 128; const int qb = 7 - (j >> 7), bh = j & 127; mla_unit(F, bh >> 3, bh & 7, qb, Qb, KVH, P, MIX); }
            UNIT_T1(it == 0, 0) UNIT_T1(it == 128, 1) UNIT_T1(it == 128 + 1023, 2)
            it = queue_take(F, nxq, 0); }
    }
    SEAM(4);
    EPI_ON(5);
    if (IN(5)) { Gemm g{MIX, (const bf16*)(ws + WS_W_ABOUT), 1536, 1536, 1536, nullptr}; pg8::StaticOrder S; S.init(T, 1024, F.G, F.bid); EpiResidNormT<false> E{A.in[I_X], XN, SSQ, 1.0f, F.lds, A.pad};
        pg8::gemm_phase<EpiResidNormT<false>, pg8::StaticOrder, false>(F.lds, g, S, E, F.wave); }
    SEAM(5);
    EPI_ON(7);
#if FFN_FP8
    if (IN(6)) { norm8_phase(F, A.in[I_FFN_NORM], (unsigned char*)XN); moe_conv_phase(F, A); }
    SEAM(6);
    if (IN(7)) { Gemm g{XN, (const bf16*)(ws + WS_W_FGU), 512, 512, 512, nullptr}; pg8::StaticOrder S; S.init(T, 7168, F.G, F.bid); EpiSwiglu8 E{(unsigned char*)HACT};
        pg8::gemm_phase<EpiSwiglu8, pg8::StaticOrder, false, true>(F.lds, g, S, E, F.wave); }
    SEAM(7);
    if (IN(8)) { Gemm g{HACT, (const bf16*)(ws + WS_W_FD), FF / 2, FF / 2, FF / 2, nullptr}; pg8::StaticOrder S; S.init(T, 1024, F.G, F.bid); EpiResid E{F.out, F.out, W8_INV};
        pg8::gemm_phase<EpiResid, pg8::StaticOrder, false, true>(F.lds, g, S, E, F.wave); }
#else
    TSTAMP(7);
#if FFN_DOWN_FP8
    if (IN(7)) { moe_conv_phase(F, A); __syncthreads();
        Gemm g{XN, (const bf16*)(ws + WS_W_FGU), 1024, 1024, 1024, nullptr}; pg8::StaticOrder S; S.init(T, 7168, F.G, F.bid); EpiSwigluO8 E{HACT, SSQ, F.lds};
        pg8::gemm_phase<EpiSwigluO8, pg8::StaticOrder, false>(F.lds, g, S, E, F.wave); }
    SEAM(7);
    EPI_ON(8);
    if (IN(8)) { Gemm g{HACT, (const bf16*)(ws + WS_W_FD), FF / 2, FF / 2, FF / 2, nullptr}; pg8::StaticOrder S; S.init(T, 1024, F.G, F.bid); EpiResidNormT<true> E{nullptr, XN, SSQ, W8_INV, F.lds, 0};
        pg8::gemm_phase<EpiResidNormT<true>, pg8::StaticOrder, false, true>(F.lds, g, S, E, F.wave); }
#else
    if (IN(7)) { Gemm g{XN, (const bf16*)(ws + WS_W_FGU), 1024, 1024, 1024, nullptr}; pg8::StaticOrder S; S.init(T, 7168, F.G, F.bid); EpiSwiglu E{HACT, SSQ, F.lds};
        pg8::gemm_phase<EpiSwiglu, pg8::StaticOrder, false>(F.lds, g, S, E, F.wave); }
    SEAM(7);
    EPI_ON(8);
    if (IN(8)) { Gemm g{HACT, (const bf16*)(ws + WS_W_FD), FF, FF, FF, nullptr}; pg8::StaticOrder S; S.init(T, 1024, F.G, F.bid); EpiResidNormT<true> E{nullptr, XN, SSQ, 1.0f, F.lds, 0};
        pg8::gemm_phase<EpiResidNormT<true>, pg8::StaticOrder, false>(F.lds, g, S, E, F.wave); }
#endif
#endif
    SEAM(8);
    TSTAMP(10);
    EPI_ON(10);
    if (IN(10)) { Gemm g{XN, (const bf16*)(ws + WS_W_CDIN), 1024, 1024, 1024, nullptr}; pg8::StaticOrder S; S.init(T, CD_IN, F.G, F.bid); EpiBf16R E{P2, CD_IN, SSQ, F.lds};
        pg8::gemm_phase<EpiBf16R, pg8::StaticOrder, false>(F.lds, g, S, E, F.wave); }
    SEAM(10);
    if (IN(11)) {
        for (int it = queue_first(F, 1); it < 1024 + 512; ) { const unsigned nxq = queue_post(F, 1);
            UNIT_T0(it == 0 || it == 512 || it == 1535)
            if (it >= 512) { const int j = it - 512; const int qb = 7 - (j >> 7), bh = j & 127; sb_unit(F, bh >> 3, bh & 7, qb, P2, MIX2); }
            else { swa_unit(F, it >> 5, (it >> 4) & 1, it & 15, P2, A.in[I_SINKS], MIX2); }
            UNIT_T1(it == 512, 3) UNIT_T1(it == 1535, 4) UNIT_T1(it == 0, 5)
            it = queue_take(F, nxq, 1); }
    }
    SEAM(11);
    EPI_ON(12);
    if (IN(12)) { Gemm g{MIX2, (const bf16*)(ws + WS_W_CDOUT), 1536, 1536, 1536, nullptr}; pg8::StaticOrder S; S.init(T, 1024, F.G, F.bid); EpiResidB16 E{XN, 1.0f};
        pg8::gemm_phase<EpiResidB16, pg8::StaticOrder, false>(F.lds, g, S, E, F.wave); }
    SEAM(12);
    if (IN(13)) { route_phase_a(F, A); xcd_barrier(bar); const MoeGeom mg = moe_geom(F); route_phase_b(F, mg); }
    SEAM(13);
    EPI_ON(14);
    if (IN(14)) {
        int npanels;
        {
            const MoeGeom mg = moe_geom(F); npanels = mg.npanels;
            volatile LAS unsigned char* pe = (volatile LAS unsigned char*)(F.lds + MISC_OFF + 512);
            for (int pnl = (F.wave * 64 + lane_id()); pnl < 272; pnl += NTHR) { int e = 0;
#pragma unroll
                for (int x = 0; x < 7; ++x) if (pnl >= mg.pend[x]) e = x + 1;
                pe[pnl] = (unsigned char)e; }
            __syncthreads();
        }
        const int nchunk = (npanels + CHUNK_PANELS - 1) / CHUNK_PANELS;
        const unsigned* slot_tok = (const unsigned*)(F.ctl + CW_SLOT_TOK); const float* slot_gate = (const float*)(F.ctl + CW_SLOT_GATE);
        const volatile LAS unsigned char* pe = (const volatile LAS unsigned char*)(F.lds + MISC_OFF + 512);
        for (int c = 0; c < nchunk; ++c) {
            const int cp0 = c * CHUNK_PANELS, cpn = (npanels - cp0) < CHUNK_PANELS ? (npanels - cp0) : CHUNK_PANELS;
            { MoeOrder<28, true> S{cp0, cpn, F.G, F.bid, pe};
              Gemm g{(const bf16*)XN3, (const bf16*)(ws + WS_MOEW_GU), 512, 512, 512, slot_tok}; EpiSwiglu8 E{MACT};
              TSTAMP(20);
              pg8::gemm_phase<EpiSwiglu8, MoeOrder<28, true>, true, true>(F.lds, g, S, E, F.wave); }
            xcd_barrier(bar); TSTAMP(21); TACC(30, 20, 21);
            { MoeOrder<4, false> S{cp0, cpn, F.G, F.bid, pe};
              Gemm g{(const bf16*)MACT, (const bf16*)(ws + WS_MOEW_D), FF / 2, FF / 2, FF / 2, nullptr}; EpiMoeDown E{Y0, (long long)(WS_Y1 - WS_Y0) / 2, slot_tok, slot_gate, cp0 * 256};
              pg8::gemm_phase<EpiMoeDown, MoeOrder<4, false>, false, true>(F.lds, g, S, E, F.wave); }
            xcd_barrier(bar); TSTAMP(22); TACC(31, 21, 22);
        }
    }
    TSTAMP(15);
    if (IN(15)) final_phase(F, A);
#ifdef PROBE_MASK
    xcd_barrier(bar);
    if (F.bid == 0 && (F.wave * 64 + lane_id()) == 0) {
        const unsigned long long tend = __builtin_amdgcn_s_memrealtime(); tsv[16] = tend; unsigned long long D = 0ull;
        for (int k = 0; k < 16; ++k) if ((PROBE_MASK >> k) & 1) D += tsv[k + 1] - tsv[k];
        if ((PROBE_MASK >> 16) & 1) D += tsv[30];
        if ((PROBE_MASK >> 17) & 1) D += tsv[31];
        if ((PROBE_MASK >> 26) & 1) D += tsv[24];
        if ((PROBE_MASK >> 27) & 1) D += tsv[25];
        for (int k = 0; k < 8; ++k) if ((PROBE_MASK >> (18 + k)) & 1) D += (unsigned long long)__hip_atomic_load(F.ctl + CW_PROBE + k, RLX_AGENT);
        const unsigned long long until = tend + (unsigned long long)PROBE_MULT * D;
        while (__builtin_amdgcn_s_memrealtime() < until) __builtin_amdgcn_s_sleep(8);
    }
#endif
#undef IN
#undef SEAM
}

static int g_grid = 0;
static inline int host_setup(size_t ws_size) {
    if (g_grid) return g_grid;
    if (ws_size < WS_END) { fprintf(stderr, "kernel_launch: workspace too small: %zu < %zu\n", ws_size, (size_t)WS_END); g_grid = -1; return -1; }
    int dev = 0, cus = 0, per_cu = 0;
    if (hipGetDevice(&dev) != hipSuccess || hipDeviceGetAttribute(&cus, hipDeviceAttributeMultiprocessorCount, dev) != hipSuccess) { g_grid = -1; return -1; }
    if (hipFuncSetAttribute((const void*)mega_fwd, hipFuncAttributeMaxDynamicSharedMemorySize, LDS_BYTES) != hipSuccess) { fprintf(stderr, "kernel_launch: hipFuncSetAttribute failed\n"); g_grid = -1; return -1; }
    if (hipOccupancyMaxActiveBlocksPerMultiprocessor(&per_cu, (const void*)mega_fwd, NTHR, LDS_BYTES) != hipSuccess || per_cu < 1) fprintf(stderr, "kernel_launch: occupancy query says %d blocks per CU\n", per_cu);
    (void)hipGetLastError();
    if (cus != 256) fprintf(stderr, "kernel_launch: %d CUs (built for 256)\n", cus);
    g_grid = 256;
    return g_grid;
}
static inline void launch_range(const Args& a0, int lo, int hi, int li, hipStream_t stream) {
    Args a = a0; a.ph_lo = lo; a.ph_hi = hi; a.li = li;
    hipLaunchKernelGGL(mega_fwd, dim3(g_grid), dim3(NTHR), LDS_BYTES, stream, a);
}
}


extern "C" void kernel_launch(void* const* d_in, const int* in_sizes, int n_in, void* d_out, int out_size, void* d_ws, size_t ws_size, hipStream_t stream) {
    if (fk::host_setup(ws_size) < 0) return;
    if (hipMemsetAsync((char*)d_ws + fk::WS_CTL, 0, fk::CTL_ZERO_BYTES, stream) != hipSuccess) return;
    fk::Args a{};
    for (int i = 0; i < 23; ++i) a.in[i] = (const float*)d_in[i];
    a.out = (float*)d_out; a.ws = (unsigned char*)d_ws;
    fk::launch_range(a, 0, fk::N_PHASES, 0, stream);
}
```

```cpp
#include <hip/hip_runtime.h>
#include <cstdio>
#include <cstdint>
#include <cmath>
__device__ __forceinline__ void sincos_rev(double f, float& sn, float& cs) {
    const int k = (int)(f * 4.0 + 0.5); const double r = f - 0.25 * (double)k; const double a = 6.283185307179586476925 * r; const double a2 = a * a;
    double s = a * (1.0 + a2 * (-1.0 / 6 + a2 * (1.0 / 120 + a2 * (-1.0 / 5040 + a2 * (1.0 / 362880 + a2 * (-1.0 / 39916800 + a2 * (1.0 / 6227020800.0)))))));
    double c = 1.0 + a2 * (-0.5 + a2 * (1.0 / 24 + a2 * (-1.0 / 720 + a2 * (1.0 / 40320 + a2 * (-1.0 / 3628800 + a2 * (1.0 / 479001600.0 + a2 * (-1.0 / 87178291200.0)))))));
    const int q = k & 3; double so, co;
    if (q == 0) { so = s; co = c; } else if (q == 1) { so = c; co = -s; } else if (q == 2) { so = -s; co = -c; } else { so = -c; co = s; }
    sn = (float)so; cs = (float)co;
}
__device__ __forceinline__ void rope_cs(int pos, int i, int half, float& sn, float& cs) {
    const double r = (half == 16) ? 0.5623413251903491 : 0.7498942093324559;
    double inv = 1.0; for (int j = 0; j < i; ++j) inv *= r;
    const double rev = (double)pos * inv * 0.15915494309189533577; const double fl = (double)(long long)rev;
    sincos_rev(rev - fl, sn, cs);
}
#define GAS __attribute__((address_space(1)))
#define LAS __attribute__((address_space(3)))
#define DI __device__ __forceinline__
typedef unsigned short bf16;
typedef short bf16x8 __attribute__((ext_vector_type(8)));
typedef float f32x4 __attribute__((ext_vector_type(4)));
typedef float f32x16 __attribute__((ext_vector_type(16)));
typedef unsigned u32x4 __attribute__((ext_vector_type(4)));
typedef unsigned u32x2 __attribute__((ext_vector_type(2)));
typedef float f32x2_t __attribute__((ext_vector_type(2)));
typedef __bf16 bf16x2_t __attribute__((ext_vector_type(2)));
typedef GAS unsigned gu32;
typedef int i32x8 __attribute__((ext_vector_type(8)));
typedef int i32x4 __attribute__((ext_vector_type(4)));
#define RLX_AGENT __ATOMIC_RELAXED, __HIP_MEMORY_SCOPE_AGENT
DI unsigned pk2(float lo, float hi) { f32x2_t v = {lo, hi}; bf16x2_t b = __builtin_convertvector(v, bf16x2_t); return __builtin_bit_cast(unsigned, b); }
DI float bf_lo(unsigned u) { return __builtin_bit_cast(float, u << 16); }
DI float bf_hi(unsigned u) { return __builtin_bit_cast(float, u & 0xffff0000u); }
DI int lane_id() { int x; asm volatile("v_mbcnt_lo_u32_b32 %0, -1, 0\n\tv_mbcnt_hi_u32_b32 %0, -1, %0" : "=v"(x)); return x; }
DI float wave_sum(float v) {
#pragma unroll
    for (int o = 1; o < 64; o <<= 1) v += __shfl_xor(v, o);
    return v;
}

#define XB_TMO      128
#define XB_XCNT(j)  (256  + 64 * (j))
#define XB_XSUB(j)  (1280 + 64 * (j))
#define XB_XGEN(j)  (2304 + 64 * (j))
#define XB_TOP      3328
#define XB_TOPGEN   3392
#define XCD_BAR_WORDS 3456
#define XB_SPIN_CAP (1u << 18)
#ifndef XB_POLL_TOP
#define XB_POLL_TOP 1
#endif

__device__ __forceinline__ unsigned xb_ld(unsigned* p)              { return __hip_atomic_load(p, __ATOMIC_RELAXED, __HIP_MEMORY_SCOPE_AGENT); }
__device__ __forceinline__ unsigned xb_add(unsigned* p, unsigned v) { return __hip_atomic_fetch_add(p, v, __ATOMIC_RELAXED, __HIP_MEMORY_SCOPE_AGENT); }
__device__ __forceinline__ unsigned xb_xcc_id() { return (unsigned)__builtin_amdgcn_s_getreg((3 << 11) | 20) & 0xFu; }
#ifndef XB_SLEEP_N
#define XB_SLEEP_N 4
#endif
#ifndef XB_NOSLEEP
#define XB_NOSLEEP 0
#endif
#define XB_SPIN(cond, bar) do { unsigned _sp = 0; while (cond) { if (!XB_NOSLEEP) __builtin_amdgcn_s_sleep(XB_SLEEP_N); \
    if ((++_sp & 255u) == 0u) { if (xb_ld(&(bar)[XB_TMO])) break; if (_sp > XB_SPIN_CAP) { atomicAdd(&(bar)[XB_TMO], 1u); break; } } } } while (0)

struct XcdBarrier {
    unsigned* bar; unsigned x; unsigned w0;
    volatile LAS unsigned* st;
};

__device__ __forceinline__ XcdBarrier xcd_barrier_post(unsigned* bar, volatile LAS unsigned* st) {
    XcdBarrier b; b.bar = bar; b.x = xb_xcc_id(); b.st = st; b.w0 = (__builtin_amdgcn_readfirstlane((int)threadIdx.x >> 6) == 0) ? 1u : 0u;
    if (b.w0 && lane_id() == 0) (void)xb_add(&bar[XB_XCNT(b.x)], 1u);
    return b;
}
__device__ __forceinline__ void xcd_barrier_complete(unsigned* bar, unsigned x, unsigned& nloc, unsigned& nx) {
    const unsigned G = gridDim.x * gridDim.y * gridDim.z;
    unsigned sum, cnt, mine, sp = 0u;
    for (;;) {
        sum = 0u; cnt = 0u; mine = 0u;
#pragma unroll
        for (unsigned j = 0; j < 16; ++j) { const unsigned c = xb_ld(&bar[XB_XCNT(j)]); sum += c; cnt += (c > 0u) ? 1u : 0u; mine = (j == x) ? c : mine; }
        if (sum == G) break;
        __builtin_amdgcn_s_sleep(1);
        if ((++sp & 255u) == 0u) { if (xb_ld(&bar[XB_TMO])) break; if (sp > XB_SPIN_CAP) { atomicAdd(&bar[XB_TMO], 1u); break; } }
    }
    nloc = mine > 0u ? mine : 1u; nx = cnt > 0u ? cnt : 1u;
}

__device__ __forceinline__ void xcd_barrier(const XcdBarrier& b) {
    asm volatile("s_waitcnt vmcnt(0)" ::: "memory");
    __syncthreads();
    if (b.w0 && lane_id() == 0) {
        unsigned* bar = b.bar;
        __builtin_amdgcn_s_waitcnt(0);
        unsigned nloc = b.st[0], nx = b.st[1];
        if (nloc == 0u) { xcd_barrier_complete(bar, b.x, nloc, nx); b.st[0] = nloc; b.st[1] = nx; }
        const unsigned old = xb_add(&bar[XB_XSUB(b.x)], 1u);
        const unsigned gen = old / nloc;
        if (old + 1u == (gen + 1u) * nloc) {
            __builtin_amdgcn_fence(__ATOMIC_RELEASE, "agent");
            asm volatile("s_waitcnt vmcnt(0)" ::: "memory");
            const unsigned og = xb_add(&bar[XB_TOP], 1u);
            const unsigned tg = og / nx;
            if (og + 1u == (tg + 1u) * nx) xb_add(&bar[XB_TOPGEN], 1u);
            else XB_SPIN(xb_ld(&bar[XB_TOPGEN]) == tg, bar);
            __builtin_amdgcn_fence(__ATOMIC_ACQUIRE, "agent");
#if !XB_POLL_TOP
            xb_add(&bar[XB_XGEN(b.x)], 1u);
#endif
            asm volatile("s_waitcnt vmcnt(0)" ::: "memory");
        } else {
#if XB_POLL_TOP
            XB_SPIN(xb_ld(&bar[XB_TOPGEN]) == gen, bar);
#else
            XB_SPIN(xb_ld(&bar[XB_XGEN(b.x)]) == gen, bar);
#endif
            __builtin_amdgcn_fence(__ATOMIC_ACQUIRE, "agent");
            asm volatile("s_waitcnt vmcnt(0)" ::: "memory");
        }
    }
    __syncthreads();
}


namespace pg8 {
#define PG8_LAS __attribute__((address_space(3)))
typedef unsigned short bf16_t;
constexpr int BM = 256, BK = 64, HALF = 128, HTB = HALF * BK * 2  , STAGE_BYTES = 8 * HTB;
__host__ __device__ __forceinline__ int lds_byte(int r, int c) { const int st = (r >> 4) * 2 + (c >> 5), rr = r & 15, cc = c & 31, ob = rr * 64 + cc * 2; return st * 1024 + (ob ^ (((ob >> 9) & 1) << 5)); }
__host__ __device__ __forceinline__ void stage_rc(int b, int& R, int& C) { const int st = b / 1024, sb = b % 1024, swz = sb ^ (((sb >> 9) & 1) << 5); R = (st >> 1) * 16 + swz / 64; C = (st & 1) * 32 + (swz % 64) / 2; }
__host__ __device__ __forceinline__ int perm32(int rho) { const int n = rho >> 4, i = rho & 15; return 8 * (i >> 2) + 4 * n + (i & 3); }

struct Unit { int pm, pn, om, on, ex; };
struct Gemm { const bf16_t* A; const bf16_t* Bt; int lda, ldb, K; const unsigned* slot_tok; };

#ifndef STATIC_ROUND_MAJOR
#define STATIC_ROUND_MAJOR 0
#endif
struct StaticOrder {
    int nM, nN, nwg, G, c;
    __device__ void init(int M, int N, int G_, int c_) { nM = M / BM; nN = N / BM; nwg = nM * nN; G = G_; c = c_; }
    __device__ bool next(int i, Unit& u) const {
        const long L = (long)i * G + c;
        int wgid = (int)L;
#if STATIC_ROUND_MAJOR
        if (G == 256) { wgid = ((i * 8 + (c & 7)) * 32) + (c >> 3); if (wgid >= nwg) return false; }
        else
#endif
        { if (L >= nwg) return false; const int q = nwg / 8, r = nwg % 8, xcd = wgid % 8, off = wgid / 8; wgid = (xcd < r ? xcd * (q + 1) : r * (q + 1) + (xcd - r) * q) + off; }
        const int nig = 8 * nN, gid = wgid / nig, fm = gid * 8, gsz = (nM - fm) < 8 ? (nM - fm) : 8;
        u.pm = fm + ((wgid % nig) % gsz); u.pn = (wgid % nig) / gsz; u.om = u.pm; u.on = u.pn; u.ex = 0; return true;
    }
};

template <class Epi, class Sched, bool GATHER, bool FP8 = false>
__device__ __forceinline__ void gemm_phase(PG8_LAS unsigned char* lds, const Gemm g, const Sched& S, const Epi& E, int wave) {
    int tid = wave * 64 + lane_id(); asm volatile("" : "+v"(tid));
    const int wid = __builtin_amdgcn_readfirstlane(tid >> 6), lane = tid & 63, wr = wid >> 2, wc = wid & 3, fr = lane & 15, fq = lane >> 4;
    const int K = g.K, nt = K / BK;
    unsigned voffA[2], voffB[2];
#pragma unroll
    for (int i = 0; i < 2; ++i) { int R, C; stage_rc(tid * 16 + i * 8192, R, C); const int Rb = (R & ~31) + perm32(R & 31);
        voffA[i] = (unsigned)(R * g.lda + C) * 2u; voffB[i] = (unsigned)(Rb * g.ldb + C) * 2u; }
    const size_t kstep = (size_t)(BK * 2);
    const size_t hstepB = (size_t)HALF * g.ldb * 2, tstepB = 2 * hstepB;
    const size_t hstepA = GATHER ? (size_t)0 : (size_t)HALF * g.lda * 2, tstepA = 2 * hstepA;
    const unsigned ldsw = (unsigned)wid * 1024u;
    const int aoff = lds_byte(wr * 64 + fr, fq * 8), boff = lds_byte(wc * 32 + fr, fq * 8);
#define PG8_SA(b, h) (((b) * 2 + (h)) * HTB)
#define PG8_SB(b, h) ((4 + (b) * 2 + (h)) * HTB)
#define PG8_STAGE_B(bufoff, gbase) do { const char* _gb = (const char*)(gbase); asm volatile("" : "+s"(_gb)); _Pragma("unroll") for (int _i = 0; _i < 2; ++_i) \
        __builtin_amdgcn_global_load_lds((const unsigned*)(_gb + voffB[_i]), (PG8_LAS unsigned*)(lds + (bufoff) + ldsw + _i * 8192), 16, 0, 0); } while (0)
#define PG8_STAGE_A(bufoff, gbase, h) do { const char* _ga = (const char*)(gbase) + (size_t)(h) * hstepA; asm volatile("" : "+s"(_ga)); _Pragma("unroll") for (int _i = 0; _i < 2; ++_i) \
        __builtin_amdgcn_global_load_lds((const unsigned*)(_ga + (GATHER ? vC[h][_i] : voffA[_i])), (PG8_LAS unsigned*)(lds + (bufoff) + ldsw + _i * 8192), 16, 0, 0); } while (0)
#define PG8_SETV(V, u) do { _Pragma("unroll") for (int _h = 0; _h < 2; ++_h) _Pragma("unroll") for (int _i = 0; _i < 2; ++_i) { int _R, _C; stage_rc(tid * 16 + _i * 8192, _R, _C); \
        const unsigned _s = g.slot_tok[(size_t)(u).pm * 256 + _h * 128 + _R]; const unsigned _t = _s ? ((_s - 1u) >> 1) : 0u; (V)[_h][_i] = (_t * (unsigned)g.lda + (unsigned)_C) * 2u; } } while (0)
#define PG8_LDA(dst, b, h) do { _Pragma("unroll") for (int m = 0; m < 4; ++m) _Pragma("unroll") for (int k = 0; k < 2; ++k) dst[m][k] = *(const PG8_LAS bf16x8*)(lds + PG8_SA(b, h) + aoff + m * 2048 + k * 1024); } while (0)
#define PG8_LDB(dst, b, h) do { _Pragma("unroll") for (int n = 0; n < 2; ++n) _Pragma("unroll") for (int k = 0; k < 2; ++k) dst[n][k] = *(const PG8_LAS bf16x8*)(lds + PG8_SB(b, h) + boff + n * 2048 + k * 1024); } while (0)
#define PG8_CAT(x, y) __builtin_shufflevector(__builtin_bit_cast(i32x4, (x)), __builtin_bit_cast(i32x4, (y)), 0, 1, 2, 3, 4, 5, 6, 7)
#define PG8_MMA(ai, bj, At, Bt) do { __builtin_amdgcn_s_setprio(1); _Pragma("unroll") for (int m = 0; m < 4; ++m) _Pragma("unroll") for (int n = 0; n < 2; ++n) { \
        if constexpr (FP8) acc[ai][bj][m][n] = __builtin_amdgcn_mfma_scale_f32_16x16x128_f8f6f4(PG8_CAT(Bt[n][0], Bt[n][1]), PG8_CAT(At[m][0], At[m][1]), acc[ai][bj][m][n], 0, 0, 0, 0, 0, 0); \
        else { _Pragma("unroll") for (int k = 0; k < 2; ++k) acc[ai][bj][m][n] = __builtin_amdgcn_mfma_f32_16x16x32_bf16(Bt[n][k], At[m][k], acc[ai][bj][m][n], 0, 0, 0); } } \
        __builtin_amdgcn_s_setprio(0); } while (0)
#define PG8_MMA0(ai, bj, At, Bt) do { __builtin_amdgcn_s_setprio(1); _Pragma("unroll") for (int m = 0; m < 4; ++m) _Pragma("unroll") for (int n = 0; n < 2; ++n) { \
        if constexpr (FP8) acc[ai][bj][m][n] = __builtin_amdgcn_mfma_scale_f32_16x16x128_f8f6f4(PG8_CAT(Bt[n][0], Bt[n][1]), PG8_CAT(At[m][0], At[m][1]), (f32x4){0.f, 0.f, 0.f, 0.f}, 0, 0, 0, 0, 0, 0); \
        else { acc[ai][bj][m][n] = __builtin_amdgcn_mfma_f32_16x16x32_bf16(Bt[n][0], At[m][0], (f32x4){0.f, 0.f, 0.f, 0.f}, 0, 0, 0); \
               acc[ai][bj][m][n] = __builtin_amdgcn_mfma_f32_16x16x32_bf16(Bt[n][1], At[m][1], acc[ai][bj][m][n], 0, 0, 0); } } \
        __builtin_amdgcn_s_setprio(0); } while (0)
#define PG8_WAIT_V(n) asm volatile("s_waitcnt vmcnt(" #n ")" ::: "memory")
#define PG8_WAIT_L(n) asm volatile("s_waitcnt lgkmcnt(" #n ")" ::: "memory")
#define PG8_BAR __builtin_amdgcn_s_barrier()
#define PG8_SCHED __builtin_amdgcn_sched_barrier(0)
    Unit cur, nxt; int ui = 0;
    if (!S.next(0, cur)) return;
    f32x4 acc[2][2][4][2];
#pragma unroll
    for (int a = 0; a < 2; ++a)
#pragma unroll
        for (int b = 0; b < 2; ++b)
#pragma unroll
            for (int m = 0; m < 4; ++m)
#pragma unroll
                for (int n = 0; n < 2; ++n) acc[a][b][m][n] = (f32x4){0.f, 0.f, 0.f, 0.f};
    bf16x8 At[4][2], B0[2][2], B1[2][2];
    unsigned vC[2][2];
    if (GATHER) { PG8_SETV(vC, cur); }
    PG8_LAS unsigned* const slot_stage = (PG8_LAS unsigned*)(lds + 131072 + 2048);
    const char* cA = (const char*)g.A + (size_t)cur.pm * tstepA; const char* cB = (const char*)g.Bt + (size_t)cur.pn * tstepB;
    PG8_STAGE_B(PG8_SB(0, 0), cB); PG8_STAGE_B(PG8_SB(0, 1), cB + hstepB); PG8_STAGE_A(PG8_SA(0, 0), cA, 0); PG8_STAGE_A(PG8_SA(0, 1), cA, 1);
    if (wr == 1) PG8_BAR;
    PG8_WAIT_V(2); PG8_BAR;
    PG8_STAGE_B(PG8_SB(1, 0), cB + kstep); PG8_STAGE_A(PG8_SA(1, 0), cA + kstep, 0); PG8_STAGE_B(PG8_SB(1, 1), cB + hstepB + kstep);
    PG8_WAIT_V(6); PG8_BAR;
    for (;;) {
        const bool has_next = S.next(ui + 1, nxt);
#ifdef PROBE_MASK
        if constexpr (GATHER) if (wid == 0) { const unsigned long long _pu0 = __builtin_amdgcn_s_memrealtime(); if (lane_id() == 0) ((volatile PG8_LAS unsigned long long*)(lds + 131072 + 256))[26] = _pu0; }
#endif
        const char* nA = has_next ? (const char*)g.A + (size_t)nxt.pm * tstepA : cA; const char* nB = has_next ? (const char*)g.Bt + (size_t)nxt.pn * tstepB : cB;
        if constexpr (Epi::ROWVEC) {
            cur.ex = ui & 1;
            if (wid < 4) {
                const unsigned* _sb = (const unsigned*)E.ssq + (size_t)cur.om * 256 + wid * 64; asm volatile("" : "+s"(_sb)); const int _ln = lane_id();
#pragma unroll
                for (int _k = 0; _k < 4; ++_k) __builtin_amdgcn_global_load_lds(_sb + (size_t)_k * E.ssq_stride + _ln,
                                                                                 (PG8_LAS unsigned*)(lds + 131072 + 12288) + (ui & 1) * 1024 + _k * 256 + wid * 64, 4, 0, 0);
            }
        }
        if (GATHER) {
            if (has_next && wid < 4) __builtin_amdgcn_global_load_lds(g.slot_tok + (size_t)nxt.pm * 256 + wid * 64 + lane, slot_stage + ((ui + 1) & 1) * 256 + wid * 64, 4, 0, 0);
        }
#define PG8_KITER(t, MMAF) do { \
            const bool last = (t == nt - 2); \
            const char* a1 = cA + (size_t)(t + 1) * kstep; \
            const char* a2 = last ? nA : cA + (size_t)(t + 2) * kstep; const char* b2 = last ? nB : cB + (size_t)(t + 2) * kstep; \
            const char* a3 = a2 + kstep; const char* b3 = b2 + kstep; \
            PG8_LDB(B0, 0, 0); PG8_LDB(B1, 0, 1); PG8_SCHED; PG8_LDA(At, 0, 0); PG8_STAGE_A(PG8_SA(1, 1), a1, 1); \
            if (GATHER && last && has_next) { \
_Pragma("unroll") \
                for (int _h = 0; _h < 2; ++_h) \
_Pragma("unroll") \
                    for (int _i = 0; _i < 2; ++_i) { int _R, _C; stage_rc(tid * 16 + _i * 8192, _R, _C); const unsigned _s = slot_stage[((ui + 1) & 1) * 256 + _h * 128 + _R]; \
                        const unsigned _t = _s ? ((_s - 1u) >> 1) : 0u; vC[_h][_i] = (_t * (unsigned)g.lda + (unsigned)_C) * 2u; } \
            } \
            PG8_WAIT_V(8); PG8_WAIT_L(0); PG8_BAR; MMAF(0, 0, At, B0); MMAF(0, 1, At, B1); PG8_BAR; PG8_SCHED; \
            PG8_LDA(At, 0, 1); PG8_STAGE_B(PG8_SB(0, 0), b2); PG8_STAGE_B(PG8_SB(0, 1), b2 + hstepB); PG8_STAGE_A(PG8_SA(0, 0), a2, 0); \
            PG8_WAIT_V(8); PG8_WAIT_L(0); PG8_BAR; MMAF(1, 0, At, B0); MMAF(1, 1, At, B1); PG8_BAR; PG8_SCHED; \
            PG8_LDB(B0, 1, 0); PG8_LDB(B1, 1, 1); PG8_SCHED; PG8_LDA(At, 1, 0); PG8_STAGE_A(PG8_SA(0, 1), a2, 1); \
            PG8_WAIT_V(8); PG8_WAIT_L(0); PG8_BAR; PG8_MMA(0, 0, At, B0); PG8_MMA(0, 1, At, B1); PG8_BAR; PG8_SCHED; \
            PG8_LDA(At, 1, 1); PG8_STAGE_B(PG8_SB(1, 0), b3); PG8_STAGE_B(PG8_SB(1, 1), b3 + hstepB); PG8_STAGE_A(PG8_SA(1, 0), a3, 0); \
            PG8_WAIT_V(8); PG8_WAIT_L(0); PG8_BAR; PG8_MMA(1, 0, At, B0); PG8_MMA(1, 1, At, B1); PG8_BAR; PG8_SCHED; \
        } while (0)
#pragma clang loop unroll(disable)
        for (int t = 0; t < nt; t += 2) { PG8_KITER(t, PG8_MMA); }
#undef PG8_KITER
        if (wr == 0) PG8_BAR;
#ifdef PROBE_MASK
        unsigned long long _pe0 = 0ull; if (wid == 0) { _pe0 = __builtin_amdgcn_s_memrealtime(); volatile PG8_LAS unsigned long long* _tv2 = (volatile PG8_LAS unsigned long long*)(lds + 131072 + 256); if (GATHER && lane_id() == 0 && _tv2[23] == 1ull) _tv2[25] += _pe0 - _tv2[26]; }
#endif
        { const int _l = lane_id(); E(acc, cur, wr, wc, _l & 15, _l >> 4); }
#ifdef PROBE_MASK
        if (wid == 0) { asm volatile("s_waitcnt vmcnt(0)" ::: "memory"); const unsigned long long _pe1 = __builtin_amdgcn_s_memrealtime(); volatile PG8_LAS unsigned long long* _tv = (volatile PG8_LAS unsigned long long*)(lds + 131072 + 256);
            if (lane_id() == 0 && _tv[23] == 1ull) _tv[24] += _pe1 - _pe0; }
#endif
        if (!has_next) break;
#pragma unroll
        for (int a = 0; a < 2; ++a)
#pragma unroll
            for (int b = 0; b < 2; ++b)
#pragma unroll
                for (int m = 0; m < 4; ++m)
#pragma unroll
                    for (int n = 0; n < 2; ++n) acc[a][b][m][n] = (f32x4){0.f, 0.f, 0.f, 0.f};
        cur = nxt; cA = nA; cB = nB; ++ui;
        if (wr == 1) PG8_BAR;
    }
    PG8_WAIT_V(0);
    PG8_BAR;
#undef PG8_SA
#undef PG8_SB
#undef PG8_STAGE_A
#undef PG8_STAGE_B
#undef PG8_SETV
#undef PG8_LDA
#undef PG8_LDB
#undef PG8_MMA
#undef PG8_MMA0
#undef PG8_CAT
#undef PG8_WAIT_V
#undef PG8_WAIT_L
#undef PG8_BAR
#undef PG8_SCHED
}
}
namespace fk {
using pg8::Unit; using pg8::Gemm;
constexpr int NWAVES = 8, NTHR = 512;
constexpr int SEQ = 2048, NBATCH = 16, T = NBATCH * SEQ, DM = 1024, FF = 3584, NEXP = 8;
constexpr int AB_IN = 3744, AB_P = 3840;
constexpr int CD_IN = 2816;
constexpr int PC_QLAT = 0, PC_KVLAT = 384, PC_KROPE = 640, PC_RQ = 768, PC_RK = 1280, PC_RV = 1792, PC_RG = 2816;
constexpr int P2_SQ = 0, P2_SK = 1024, P2_SV = 1152, P2_BQ = 1280, P2_BK = 1792, P2_BV = 2304;
constexpr float EPS = 1e-6f;
constexpr float LOG2E = 1.4426950408889634f;
constexpr int MOE_CAP = 2 * T + NEXP * 256;
#ifndef FFN_DOWN_FP8
#define FFN_DOWN_FP8 1
#endif
#ifndef FFN_FP8
#ifndef OUTPROJ2_FP8
#define OUTPROJ2_FP8 1
#endif
#ifndef OUTPROJ_FP8
#define OUTPROJ_FP8 0
#endif
#define FFN_FP8 0
#endif
constexpr int CHUNK_PANELS = 128;
constexpr float MIX_SCALE = 16.0f, MIX_INV = 1.0f / MIX_SCALE;
constexpr float W8_SCALE = 64.0f, W8_INV = 1.0f / 64.0f;

constexpr size_t MiB = 1u << 20;
constexpr size_t WS_CTL = 0, CTL_ZERO_BYTES = 802816;
constexpr size_t WS_TAB = 1 * MiB;
constexpr size_t WS_CS16 = WS_TAB, WS_CS32 = WS_TAB + 262144;
constexpr size_t WS_W = 2 * MiB;
constexpr size_t WS_W_ABIN = WS_W;
constexpr size_t WS_W_UQ = WS_W_ABIN + (size_t)AB_P * 1024 * 2;
constexpr size_t WS_W_UKV = WS_W_UQ + (size_t)768 * 384 * 2;
constexpr size_t WS_W_ABOUT = WS_W_UKV + (size_t)1024 * 256 * 2;
constexpr size_t WS_W_FGU = WS_W_ABOUT + (size_t)1024 * 1536 * 2;
constexpr size_t WS_W_FD = WS_W_FGU + (size_t)7168 * 1024 * 2;
constexpr size_t WS_W_CDIN = WS_W_FD + (size_t)1024 * 3584 * 2;
constexpr size_t WS_W_CDOUT = WS_W_CDIN + (size_t)2816 * 1024 * 2;
constexpr size_t WS_W_END = WS_W_CDOUT + (size_t)1024 * 1536 * 2;
constexpr size_t WS_SSQ = 43 * MiB + 256 * 1024;
static_assert(WS_W_END <= WS_SSQ && WS_SSQ + (size_t)4 * T * 4 <= 44 * MiB, "small weights + ssq fit [2,44) MiB");
constexpr size_t WS_SSQX = 43 * MiB + 768 * 1024;
constexpr size_t WS_ACT = 44 * MiB;
constexpr size_t WS_P = WS_ACT;
constexpr size_t WS_XN = 284 * MiB;
constexpr size_t WS_KVH = 284 * MiB;
constexpr size_t WS_Q = 348 * MiB;
constexpr size_t WS_MIXED = 396 * MiB;
constexpr size_t WS_HACT = WS_ACT;
constexpr size_t WS_P2 = WS_ACT;
constexpr size_t WS_MIXED2 = 348 * MiB;
constexpr size_t WS_MACT = WS_ACT;
constexpr size_t XN3_OUT_OFF = 64 * MiB;
constexpr size_t WS_Y0 = 188 * MiB, WS_Y1 = 348 * MiB;
constexpr size_t WS_MOEW = 461 * MiB;
constexpr size_t WS_MOEW_GU = WS_MOEW, WS_MOEW_D = WS_MOEW + (size_t)NEXP * 7168 * 1024;
constexpr size_t WS_END = 545 * MiB;
static_assert(WS_MOEW_D + (size_t)NEXP * 1024 * 3584 <= WS_END, "ws map end");
constexpr int CW_TMO = 0, CW_CODE = 1;
constexpr int CW_QUEUE = 64;
constexpr int CW_PROBE = 2048;
constexpr int CW_ECNT = 1024;
constexpr int CW_BAR = 4096;
constexpr int CW_SLOT_TOK = 65536;
constexpr int CW_SLOT_GATE = CW_SLOT_TOK + MOE_CAP;
constexpr int CW_TAILFLAG = 204800;
static_assert(CW_SLOT_GATE + MOE_CAP <= CW_TAILFLAG && (size_t)(CW_SLOT_GATE + MOE_CAP) * 4 <= CTL_ZERO_BYTES, "ctl fits");
static_assert(CW_BAR + 16 * 3456 <= CW_SLOT_TOK, "barrier regions");

constexpr int RING_BYTES = 131072;
constexpr int MISC_OFF = RING_BYTES;
constexpr int LDS_BYTES = 151552;

struct Frame {
    LAS unsigned char* lds;
    volatile LAS unsigned* MISC;
    gu32* ctl;
    unsigned char* ws;
    int wave, G, bid;
    float* out;
};
struct Args { const float* in[23]; float* out; unsigned char* ws; int ph_lo, ph_hi, li, pad; };

DI unsigned pk4_fp8(float a, float b, float c, float d) { int w = 0; w = __builtin_amdgcn_cvt_pk_fp8_f32(a, b, w, false); w = __builtin_amdgcn_cvt_pk_fp8_f32(c, d, w, true); return (unsigned)w; }
DI float row_rstd_lds(LAS unsigned char* lds, int par, int lrow) { const LAS float* st = (const LAS float*)(lds + 131072 + 12288) + par * 1024 + lrow; return __builtin_amdgcn_rsqf((st[0] + st[256] + st[512] + st[768]) * (1.0f / DM) + EPS); }
DI float row_msq_lds(LAS unsigned char* lds, int par, int lrow) { const LAS float* st = (const LAS float*)(lds + 131072 + 12288) + par * 1024 + lrow; return (st[0] + st[256] + st[512] + st[768]) * (1.0f / DM) + EPS; }
DI float rstd_part(LAS unsigned char* lds, int par, int lrow, int first, float inv_n) { const LAS float* st = (const LAS float*)(lds + 131072 + 12288) + par * 1024 + first * 256 + lrow; return __builtin_amdgcn_rsqf((st[0] + st[256]) * inv_n + EPS); }
DI float row_rstd(const float* ssq, int row) { return 1.0f / sqrtf((ssq[row] + ssq[T + row] + ssq[2 * T + row] + ssq[3 * T + row]) * (1.0f / DM) + EPS); }
template <bool RV> struct EpiBf16T {
    static constexpr bool ROWVEC = RV; static constexpr int ssq_stride = T;
    bf16* O; int ldc; const float* ssq; LAS unsigned char* lds;
    DI void operator()(const f32x4 (&acc)[2][2][4][2], const Unit& u, int wr, int wc, int fr, int fq) const {
        const int row0 = u.om * 256 + wr * 64 + fr, col0 = u.on * 256 + wc * 32 + 8 * fq;
#pragma unroll
        for (int ai = 0; ai < 2; ++ai)
#pragma unroll
            for (int m = 0; m < 4; ++m) { bf16* rowp = O + (size_t)(row0 + ai * 128 + m * 16) * ldc + col0; const float rs = RV ? row_rstd_lds(lds, u.ex, wr * 64 + fr + ai * 128 + m * 16) : 1.0f;
#pragma unroll
                for (int bj = 0; bj < 2; ++bj) { const f32x4 v0 = acc[ai][bj][m][0] * rs, v1 = acc[ai][bj][m][1] * rs;
                    u32x4 w; w.x = pk2(v0[0], v0[1]); w.y = pk2(v0[2], v0[3]); w.z = pk2(v1[0], v1[1]); w.w = pk2(v1[2], v1[3]);
                    *(u32x4*)(rowp + bj * 128) = w; } }
    }
};
typedef EpiBf16T<false> EpiBf16; typedef EpiBf16T<true> EpiBf16R;
struct EpiKvh {
    static constexpr bool ROWVEC = true; static constexpr int ssq_stride = T;
    bf16* O; const float* ssq; LAS unsigned char* lds;
    DI void operator()(const f32x4 (&acc)[2][2][4][2], const Unit& u, int wr, int wc, int fr, int fq) const {
        const int row0 = u.om * 256 + wr * 64 + fr, col0 = u.on * 256 + wc * 32 + 8 * fq;
#pragma unroll
        for (int ai = 0; ai < 2; ++ai)
#pragma unroll
            for (int m = 0; m < 4; ++m) { bf16* rowp = O + (size_t)(row0 + ai * 128 + m * 16) * 1024 + col0; const float rs = rstd_part(lds, u.ex, wr * 64 + fr + ai * 128 + m * 16, 2, 1.0f / 256.0f);
#pragma unroll
                for (int bj = 0; bj < 2; ++bj) { const f32x4 v0 = acc[ai][bj][m][0] * rs, v1 = acc[ai][bj][m][1] * rs;
                    u32x4 w; w.x = pk2(v0[0], v0[1]); w.y = pk2(v0[2], v0[3]); w.z = pk2(v1[0], v1[1]); w.w = pk2(v1[2], v1[3]);
                    *(u32x4*)(rowp + bj * 128) = w; } }
    }
};
struct EpiP {
    static constexpr bool ROWVEC = true; static constexpr int ssq_stride = 0;
    bf16* O; const float2* cs32; const float2* cs16; float* ssq_out; LAS unsigned char* lds; const float* ssq;
    DI void operator()(const f32x4 (&acc)[2][2][4][2], const Unit& u, int wr, int wc, int fr, int fq) const {
        const int row0 = u.om * 256 + wr * 64 + fr;
        if (u.on < 3 || u.on > 6) {
            const int col0 = u.on * 256 + wc * 32 + 8 * fq; const bool stats = u.on <= 2;
            LAS float* tab = (LAS float*)(lds + 131072 + 4096);
#pragma unroll
            for (int ai = 0; ai < 2; ++ai)
#pragma unroll
                for (int m = 0; m < 4; ++m) { const int row = row0 + ai * 128 + m * 16; bf16* rowp = O + (size_t)row * AB_P + col0; float ssb[2] = {0.f, 0.f}; const float rs = row_rstd_lds(lds, u.ex, wr * 64 + fr + ai * 128 + m * 16);
#pragma unroll
                    for (int bj = 0; bj < 2; ++bj) { f32x4 v0 = acc[ai][bj][m][0] * rs, v1 = acc[ai][bj][m][1] * rs;
                        if (bj == 1 && u.on == 2 && wc == 0) {
                            const int pos = row & (SEQ - 1); const float2* cs = cs16 + pos * 16 + 8 * (fq & 1);
                            f32x4 o0, o1;
#pragma unroll
                            for (int j = 0; j < 4; ++j) { const float p0 = __shfl_xor(v0[j], 32), p1 = __shfl_xor(v1[j], 32); const float2 t0 = cs[j], t1 = cs[4 + j];
                                o0[j] = (fq < 2) ? (v0[j] * t0.x - p0 * t0.y) : (p0 * t0.y + v0[j] * t0.x);
                                o1[j] = (fq < 2) ? (v1[j] * t1.x - p1 * t1.y) : (p1 * t1.y + v1[j] * t1.x); }
                            v0 = o0; v1 = o1; }
                        u32x4 w; w.x = pk2(v0[0], v0[1]); w.y = pk2(v0[2], v0[3]); w.z = pk2(v1[0], v1[1]); w.w = pk2(v1[2], v1[3]);
                        *(u32x4*)(rowp + bj * 128) = w;
                        ssb[bj] = (v0[0] * v0[0] + v0[1] * v0[1]) + (v0[2] * v0[2] + v0[3] * v0[3]) + (v1[0] * v1[0] + v1[1] * v1[1]) + (v1[2] * v1[2] + v1[3] * v1[3]); }
                    if (stats) {
#pragma unroll
                        for (int bj = 0; bj < 2; ++bj) { float ss = ssb[bj]; ss += __shfl_xor(ss, 16); ss += __shfl_xor(ss, 32); if (fq == 0) tab[bj * 1024 + wc * 256 + ai * 128 + wr * 64 + m * 16 + fr] = ss; } } }
            if (stats) {
                asm volatile("s_waitcnt lgkmcnt(0)" ::: "memory"); __builtin_amdgcn_s_barrier();
                const int t = (wr * 4 + wc) * 64 + fq * 16 + fr;
                if (t < 256) { const float s0 = (tab[t] + tab[256 + t]) + (tab[512 + t] + tab[768 + t]), s1 = (tab[1024 + t] + tab[1280 + t]) + (tab[1536 + t] + tab[1792 + t]); const size_t gr = (size_t)u.om * 256 + t;
                    if (u.on == 0) ssq_out[gr] = s0 + s1; else if (u.on == 1) { ssq_out[(size_t)T + gr] = s0; ssq_out[(size_t)2 * T + gr] = s1; } else ssq_out[(size_t)3 * T + gr] = s0; }
            }
        } else {
            const int which = u.on >= 5, head = 4 * ((u.on - 3) & 1) + wc, i0 = 8 * fq;
            const float lg2 = log1pf(-__builtin_amdgcn_exp2f(-5.0f - (float)head)) * LOG2E;
            bf16* obase = O + (which ? PC_RK : PC_RQ) + head * 64 + i0;
#pragma unroll
            for (int ai = 0; ai < 2; ++ai)
#pragma unroll
                for (int m = 0; m < 4; ++m) { const int row = row0 + ai * 128 + m * 16; const int pos = row & (SEQ - 1); const float ql = (float)(pos & 127);
                    const float sc = (which ? 0.125f * __builtin_amdgcn_exp2f(-ql * lg2) : __builtin_amdgcn_exp2f(ql * lg2)) * row_rstd_lds(lds, u.ex, wr * 64 + fr + ai * 128 + m * 16);
                    const float2* cs = cs32 + pos * 32 + i0;
                    float o1[8], o2[8];
#pragma unroll
                    for (int n = 0; n < 2; ++n)
#pragma unroll
                        for (int j = 0; j < 4; j += 2) { const f32x4 t2 = *(const f32x4*)(cs + n * 4 + j);
                            { const float x1 = acc[ai][0][m][n][j], x2 = acc[ai][1][m][n][j]; o1[n * 4 + j] = (x1 * t2[0] - x2 * t2[1]) * sc; o2[n * 4 + j] = (x1 * t2[1] + x2 * t2[0]) * sc; }
                            { const float x1 = acc[ai][0][m][n][j + 1], x2 = acc[ai][1][m][n][j + 1]; o1[n * 4 + j + 1] = (x1 * t2[2] - x2 * t2[3]) * sc; o2[n * 4 + j + 1] = (x1 * t2[3] + x2 * t2[2]) * sc; } }
                    u32x4 w1, w2; w1.x = pk2(o1[0], o1[1]); w1.y = pk2(o1[2], o1[3]); w1.z = pk2(o1[4], o1[5]); w1.w = pk2(o1[6], o1[7]);
                    w2.x = pk2(o2[0], o2[1]); w2.y = pk2(o2[2], o2[3]); w2.z = pk2(o2[4], o2[5]); w2.w = pk2(o2[6], o2[7]);
                    bf16* qp = obase + (size_t)row * AB_P;
                    *(u32x4*)(qp) = w1; *(u32x4*)(qp + 32) = w2; }
        }
    }
};
struct EpiQ {
    static constexpr bool ROWVEC = true; static constexpr int ssq_stride = T;
    bf16* Q; const float2* cs16; const float* ssq; LAS unsigned char* lds;
    DI void operator()(const f32x4 (&acc)[2][2][4][2], const Unit& u, int wr, int wc, int fr, int fq) const {
        const int row0 = u.om * 256 + wr * 64 + fr;
        if (u.on < 2) {
#pragma unroll
            for (int ai = 0; ai < 2; ++ai)
#pragma unroll
                for (int m = 0; m < 4; ++m) { const int row = row0 + ai * 128 + m * 16; const float rs = rstd_part(lds, u.ex, wr * 64 + fr + ai * 128 + m * 16, 0, 1.0f / 384.0f);
#pragma unroll
                    for (int bj = 0; bj < 2; ++bj) { const int c = bj * 128 + wc * 32 + 8 * fq; const int hd = 4 * u.on + (c >> 6), d = c & 63;
                        const f32x4 v0 = acc[ai][bj][m][0] * rs, v1 = acc[ai][bj][m][1] * rs;
                        u32x4 w; w.x = pk2(v0[0], v0[1]); w.y = pk2(v0[2], v0[3]); w.z = pk2(v1[0], v1[1]); w.w = pk2(v1[2], v1[3]);
                        *(u32x4*)(Q + (size_t)row * 768 + hd * 96 + d) = w; } }
        } else {
            const int c = wc * 32 + 8 * fq; const int hd = c >> 4, i0 = c & 15;
#pragma unroll
            for (int ai = 0; ai < 2; ++ai)
#pragma unroll
                for (int m = 0; m < 4; ++m) { const int row = row0 + ai * 128 + m * 16; const int pos = row & (SEQ - 1); const float rs = rstd_part(lds, u.ex, wr * 64 + fr + ai * 128 + m * 16, 0, 1.0f / 384.0f);
                    const float2* cs = cs16 + pos * 16 + i0;
                    float o1[8], o2[8];
#pragma unroll
                    for (int n = 0; n < 2; ++n)
#pragma unroll
                        for (int j = 0; j < 4; ++j) { const float2 t = cs[n * 4 + j]; const float x1 = acc[ai][0][m][n][j] * rs, x2 = acc[ai][1][m][n][j] * rs;
                            o1[n * 4 + j] = x1 * t.x - x2 * t.y; o2[n * 4 + j] = x1 * t.y + x2 * t.x; }
                    u32x4 w1, w2; w1.x = pk2(o1[0], o1[1]); w1.y = pk2(o1[2], o1[3]); w1.z = pk2(o1[4], o1[5]); w1.w = pk2(o1[6], o1[7]);
                    w2.x = pk2(o2[0], o2[1]); w2.y = pk2(o2[2], o2[3]); w2.z = pk2(o2[4], o2[5]); w2.w = pk2(o2[6], o2[7]);
                    bf16* qp = Q + (size_t)row * 768 + hd * 96 + 64 + i0;
                    *(u32x4*)(qp) = w1; *(u32x4*)(qp + 16) = w2; }
        }
    }
};
struct EpiResid {
    static constexpr bool ROWVEC = false;
    const float* R; float* O; float sc;
    DI void operator()(const f32x4 (&acc)[2][2][4][2], const Unit& u, int wr, int wc, int fr, int fq) const {
        const int row0 = u.om * 256 + wr * 64 + fr, col0 = u.on * 256 + wc * 32 + 8 * fq;
#pragma unroll
        for (int ai = 0; ai < 2; ++ai)
#pragma unroll
            for (int m = 0; m < 4; ++m) { const size_t off = (size_t)(row0 + ai * 128 + m * 16) * DM + col0;
#pragma unroll
                for (int bj = 0; bj < 2; ++bj) { const f32x4 r0 = *(const f32x4*)(R + off + bj * 128), r1 = *(const f32x4*)(R + off + bj * 128 + 4);
                    *(f32x4*)(O + off + bj * 128) = r0 + acc[ai][bj][m][0] * sc; *(f32x4*)(O + off + bj * 128 + 4) = r1 + acc[ai][bj][m][1] * sc; } }
    }
};
template <bool RB16> struct EpiResidNormT {
    static constexpr bool ROWVEC = false;
    const float* R; bf16* HB; float* ssq; float sc; LAS unsigned char* lds; int xf;
    DI void operator()(const f32x4 (&acc)[2][2][4][2], const Unit& u, int wr, int wc, int fr, int fq) const {
        const int row0 = u.om * 256 + wr * 64 + fr, col0 = u.on * 256 + wc * 32 + 8 * fq;
        LAS float* tab = (LAS float*)(lds + 131072 + 4096);
#pragma unroll
        for (int ai = 0; ai < 2; ++ai)
#pragma unroll
            for (int m = 0; m < 4; ++m) { const size_t off = (size_t)(row0 + ai * 128 + m * 16) * DM + col0; float ss = 0.f;
#pragma unroll
                for (int bj = 0; bj < 2; ++bj) { f32x4 r0, r1;
                    if constexpr (RB16) { const u32x4 rb = *(const u32x4*)(HB + off + bj * 128); r0 = (f32x4){bf_lo(rb.x), bf_hi(rb.x), bf_lo(rb.y), bf_hi(rb.y)}; r1 = (f32x4){bf_lo(rb.z), bf_hi(rb.z), bf_lo(rb.w), bf_hi(rb.w)}; }
                    else { const int rw = row0 + ai * 128 + m * 16; const size_t ro = xf ? (size_t)((rw & ~(SEQ - 1)) | (SEQ - 1 - (rw & (SEQ - 1)))) * DM + col0 : off; const float sg = xf ? -1.0f : 1.0f;
                        r0 = *(const f32x4*)(R + ro + bj * 128) * sg; r1 = *(const f32x4*)(R + ro + bj * 128 + 4) * sg; }
                    const f32x4 v0 = r0 + acc[ai][bj][m][0] * sc, v1 = r1 + acc[ai][bj][m][1] * sc;
                    u32x4 w; w.x = pk2(v0[0], v0[1]); w.y = pk2(v0[2], v0[3]); w.z = pk2(v1[0], v1[1]); w.w = pk2(v1[2], v1[3]);
                    *(u32x4*)(HB + off + bj * 128) = w;
                    ss += (v0[0] * v0[0] + v0[1] * v0[1]) + (v0[2] * v0[2] + v0[3] * v0[3]) + (v1[0] * v1[0] + v1[1] * v1[1]) + (v1[2] * v1[2] + v1[3] * v1[3]); }
                ss += __shfl_xor(ss, 16); ss += __shfl_xor(ss, 32);
                if (fq == 0) tab[wc * 256 + ai * 128 + wr * 64 + m * 16 + fr] = ss; }
        asm volatile("s_waitcnt lgkmcnt(0)" ::: "memory"); __builtin_amdgcn_s_barrier();
        const int t = (wr * 4 + wc) * 64 + fq * 16 + fr;
        if (t < 256) ssq[(size_t)u.on * T + u.om * 256 + t] = (tab[t] + tab[256 + t]) + (tab[512 + t] + tab[768 + t]);
    }
};
struct EpiResidB16 {
    static constexpr bool ROWVEC = false;
    bf16* HB; float sc;
    DI void operator()(const f32x4 (&acc)[2][2][4][2], const Unit& u, int wr, int wc, int fr, int fq) const {
        const int row0 = u.om * 256 + wr * 64 + fr, col0 = u.on * 256 + wc * 32 + 8 * fq;
#pragma unroll
        for (int ai = 0; ai < 2; ++ai)
#pragma unroll
            for (int m = 0; m < 4; ++m) { const size_t off = (size_t)(row0 + ai * 128 + m * 16) * DM + col0;
#pragma unroll
                for (int bj = 0; bj < 2; ++bj) { const u32x4 rb = *(const u32x4*)(HB + off + bj * 128);
                    const f32x4 v0 = (f32x4){bf_lo(rb.x), bf_hi(rb.x), bf_lo(rb.y), bf_hi(rb.y)} + acc[ai][bj][m][0] * sc, v1 = (f32x4){bf_lo(rb.z), bf_hi(rb.z), bf_lo(rb.w), bf_hi(rb.w)} + acc[ai][bj][m][1] * sc;
                    u32x4 w; w.x = pk2(v0[0], v0[1]); w.y = pk2(v0[2], v0[3]); w.z = pk2(v1[0], v1[1]); w.w = pk2(v1[2], v1[3]);
                    *(u32x4*)(HB + off + bj * 128) = w; } }
    }
};
DI float silu_f(float x) { return x * __builtin_amdgcn_rcpf(1.0f + __builtin_amdgcn_exp2f(-x * LOG2E)); }
DI float swiglu_raw(float ag, float au, float k, float sh, float c) { return (ag * au) * __builtin_amdgcn_rcpf(c + __builtin_amdgcn_exp2f(__builtin_fmaf(ag, k, sh))); }
DI f32x2_t swiglu_raw2(f32x2_t ag, f32x2_t au, float k, float sh, float c) {
    const f32x2_t z = __builtin_elementwise_fma(ag, (f32x2_t){k, k}, (f32x2_t){sh, sh});
    const f32x2_t d = (f32x2_t){c, c} + (f32x2_t){__builtin_amdgcn_exp2f(z.x), __builtin_amdgcn_exp2f(z.y)};
    return (ag * au) * (f32x2_t){__builtin_amdgcn_rcpf(d.x), __builtin_amdgcn_rcpf(d.y)};
}
template <bool OUT8> struct EpiSwigluT {
    static constexpr bool ROWVEC = true; static constexpr int ssq_stride = T;
    bf16* O; const float* ssq; LAS unsigned char* lds;
    DI void operator()(const f32x4 (&acc)[2][2][4][2], const Unit& u, int wr, int wc, int fr, int fq) const {
        const int row0 = u.om * 256 + wr * 64 + fr, col0 = u.on * 128 + wc * 32 + 8 * fq;
#pragma unroll
        for (int ai = 0; ai < 2; ++ai)
#pragma unroll
            for (int m = 0; m < 4; ++m) { bf16* rowp = O + (size_t)(row0 + ai * 128 + m * 16) * FF + col0; const float c = row_msq_lds(lds, u.ex, wr * 64 + fr + ai * 128 + m * 16), k = -LOG2E * __builtin_amdgcn_rsqf(c), sh = __builtin_amdgcn_logf(c);
                float o[8];
#pragma unroll
                for (int n = 0; n < 2; ++n)
#pragma unroll
                    for (int j = 0; j < 4; j += 2) { const f32x4 g4 = acc[ai][0][m][n], u4 = acc[ai][1][m][n];
                        const f32x2_t r2 = swiglu_raw2((f32x2_t){g4[j], g4[j + 1]}, (f32x2_t){u4[j], u4[j + 1]}, k, sh, c); o[n * 4 + j] = r2.x; o[n * 4 + j + 1] = r2.y; }
                if constexpr (OUT8) { u32x2 w8; w8.x = pk4_fp8(o[0], o[1], o[2], o[3]); w8.y = pk4_fp8(o[4], o[5], o[6], o[7]); *(u32x2*)((unsigned char*)O + (size_t)(row0 + ai * 128 + m * 16) * FF + col0) = w8; }
                else { u32x4 w; w.x = pk2(o[0], o[1]); w.y = pk2(o[2], o[3]); w.z = pk2(o[4], o[5]); w.w = pk2(o[6], o[7]); *(u32x4*)rowp = w; } }
    }
};
typedef EpiSwigluT<false> EpiSwiglu; typedef EpiSwigluT<true> EpiSwigluO8;
struct EpiSwiglu8 {
    static constexpr bool ROWVEC = false;
    unsigned char* O;
    DI void operator()(const f32x4 (&acc)[2][2][4][2], const Unit& u, int wr, int wc, int fr, int fq) const {
        const int row0 = u.om * 256 + wr * 64 + fr, col0 = u.on * 128 + wc * 32 + 8 * fq;
#pragma unroll
        for (int ai = 0; ai < 2; ++ai)
#pragma unroll
            for (int m = 0; m < 4; ++m) { unsigned char* rowp = O + (size_t)(row0 + ai * 128 + m * 16) * FF + col0;
                float o[8];
#pragma unroll
                for (int n = 0; n < 2; ++n)
#pragma unroll
                    for (int j = 0; j < 4; j += 2) { const f32x4 g4 = acc[ai][0][m][n], u4 = acc[ai][1][m][n];
                        const f32x2_t r2 = swiglu_raw2((f32x2_t){g4[j], g4[j + 1]}, (f32x2_t){u4[j], u4[j + 1]}, -LOG2E * W8_INV, 12.0f, 4096.0f); o[n * 4 + j] = r2.x; o[n * 4 + j + 1] = r2.y; }
                u32x2 w; w.x = pk4_fp8(o[0], o[1], o[2], o[3]); w.y = pk4_fp8(o[4], o[5], o[6], o[7]);
                *(u32x2*)rowp = w; }
    }
};
#ifndef MOE_Y_NT
#define MOE_Y_NT 0
#endif
struct EpiMoeDown {
    static constexpr bool ROWVEC = false;
    bf16* Y0; long long ydelta; const unsigned* slot_tok; const float* slot_gate; int slot_base;
    DI void operator()(const f32x4 (&acc)[2][2][4][2], const Unit& u, int wr, int wc, int fr, int fq) const {
        const int row0 = u.om * 256 + wr * 64 + fr, col0 = u.on * 256 + wc * 32 + 8 * fq;
#pragma unroll
        for (int ai = 0; ai < 2; ++ai)
#pragma unroll
            for (int m = 0; m < 4; ++m) { const int slot = slot_base + row0 + ai * 128 + m * 16; const unsigned s = slot_tok[slot];
                if (s) { const unsigned tk = s - 1u; const size_t off = (size_t)(tk >> 1) * DM + col0; bf16* Y = Y0 + (long long)(tk & 1u) * ydelta; const float gt = slot_gate[slot] * W8_INV;
#pragma unroll
                    for (int bj = 0; bj < 2; ++bj) { const f32x4 v0 = acc[ai][bj][m][0] * gt, v1 = acc[ai][bj][m][1] * gt;
                        u32x4 w; w.x = pk2(v0[0], v0[1]); w.y = pk2(v0[2], v0[3]); w.z = pk2(v1[0], v1[1]); w.w = pk2(v1[2], v1[3]);
#if MOE_Y_NT
                        __builtin_nontemporal_store(w, (u32x4*)(Y + off + bj * 128));
#else
                        *(u32x4*)(Y + off + bj * 128) = w;
#endif
                        } } }
    }
};

DI void conv_item(const float* W, int N, bf16* WT, int ldk, int dst_row0, int src_col0, int k0, float scale, LAS float* scr, int lane, const float* kgain = nullptr) {
    if (src_col0 >= 0) {
        float wv[32];
#pragma unroll
        for (int i = 0; i < 32; ++i) { const int kk = 2 * i + (lane >> 5); wv[i] = __builtin_nontemporal_load(W + (size_t)(k0 + kk) * N + src_col0 + (lane & 31));        }
#pragma unroll
        for (int i = 0; i < 32; ++i) { const int kk = 2 * i + (lane >> 5); scr[kk * 33 + (lane & 31)] = wv[i] * (kgain ? scale * kgain[k0 + kk] : scale); }
    } else {
#pragma unroll 8
        for (int i = 0; i < 32; ++i) { const int kk = 2 * i + (lane >> 5); scr[kk * 33 + (lane & 31)] = 0.f; }
    }
    asm volatile("s_waitcnt lgkmcnt(0)" ::: "memory");
    const int c = lane & 7;
#pragma unroll
    for (int j = 0; j < 4; ++j) { const int n = (lane >> 3) + 8 * j; const LAS float* s = scr + (8 * c) * 33 + n;
        u32x4 o; o.x = pk2(s[0 * 33], s[1 * 33]); o.y = pk2(s[2 * 33], s[3 * 33]); o.z = pk2(s[4 * 33], s[5 * 33]); o.w = pk2(s[6 * 33], s[7 * 33]);
        *(GAS u32x4*)(WT + (size_t)(dst_row0 + n) * ldk + k0 + 8 * c) = o; }
    asm volatile("s_waitcnt lgkmcnt(0)" ::: "memory");
}
DI void conv_item8(const float* W, int N, unsigned char* WT, int ldk, int dst_row0, int src_col0, int k0, float scale, LAS float* scr, int lane) {
    float wv[32];
#pragma unroll
    for (int i = 0; i < 32; ++i) { const int kk = 2 * i + (lane >> 5); wv[i] = __builtin_nontemporal_load(W + (size_t)(k0 + kk) * N + src_col0 + (lane & 31));        }
#pragma unroll
    for (int i = 0; i < 32; ++i) { const int kk = 2 * i + (lane >> 5); scr[kk * 33 + (lane & 31)] = wv[i] * scale; }
    asm volatile("s_waitcnt lgkmcnt(0)" ::: "memory");
    const int n = lane >> 1, kh = (lane & 1) * 32; const LAS float* sp = scr + kh * 33 + n;
    u32x4 o0, o1;
    o0.x = pk4_fp8(sp[0 * 33], sp[1 * 33], sp[2 * 33], sp[3 * 33]); o0.y = pk4_fp8(sp[4 * 33], sp[5 * 33], sp[6 * 33], sp[7 * 33]);
    o0.z = pk4_fp8(sp[8 * 33], sp[9 * 33], sp[10 * 33], sp[11 * 33]); o0.w = pk4_fp8(sp[12 * 33], sp[13 * 33], sp[14 * 33], sp[15 * 33]);
    o1.x = pk4_fp8(sp[16 * 33], sp[17 * 33], sp[18 * 33], sp[19 * 33]); o1.y = pk4_fp8(sp[20 * 33], sp[21 * 33], sp[22 * 33], sp[23 * 33]);
    o1.z = pk4_fp8(sp[24 * 33], sp[25 * 33], sp[26 * 33], sp[27 * 33]); o1.w = pk4_fp8(sp[28 * 33], sp[29 * 33], sp[30 * 33], sp[31 * 33]);
    GAS unsigned char* dp = (GAS unsigned char*)WT + (size_t)(dst_row0 + n) * ldk + k0 + kh;
    *(GAS u32x4*)dp = o0; *(GAS u32x4*)(dp + 16) = o1;
    asm volatile("s_waitcnt lgkmcnt(0)" ::: "memory");
}
DI void conv8_load(float (&wv)[32], const float* W, int N, int src_col0, int k0, int lane) {
#pragma unroll
    for (int i = 0; i < 32; ++i) { const int kk = 2 * i + (lane >> 5); wv[i] = __builtin_nontemporal_load(W + (size_t)(k0 + kk) * N + src_col0 + (lane & 31)); }
}
DI void conv8_store(const float (&wv)[32], unsigned char* WT, int ldk, int dst_row0, int k0, float scale, LAS float* scr, int lane) {
#pragma unroll
    for (int i = 0; i < 32; ++i) { const int kk = 2 * i + (lane >> 5); scr[kk * 33 + (lane & 31)] = wv[i] * scale; }
    asm volatile("s_waitcnt lgkmcnt(0)" ::: "memory");
    const int n = lane >> 1, kh = (lane & 1) * 32; const LAS float* sp = scr + kh * 33 + n;
    u32x4 o0, o1;
    o0.x = pk4_fp8(sp[0 * 33], sp[1 * 33], sp[2 * 33], sp[3 * 33]); o0.y = pk4_fp8(sp[4 * 33], sp[5 * 33], sp[6 * 33], sp[7 * 33]);
    o0.z = pk4_fp8(sp[8 * 33], sp[9 * 33], sp[10 * 33], sp[11 * 33]); o0.w = pk4_fp8(sp[12 * 33], sp[13 * 33], sp[14 * 33], sp[15 * 33]);
    o1.x = pk4_fp8(sp[16 * 33], sp[17 * 33], sp[18 * 33], sp[19 * 33]); o1.y = pk4_fp8(sp[20 * 33], sp[21 * 33], sp[22 * 33], sp[23 * 33]);
    o1.z = pk4_fp8(sp[24 * 33], sp[25 * 33], sp[26 * 33], sp[27 * 33]); o1.w = pk4_fp8(sp[28 * 33], sp[29 * 33], sp[30 * 33], sp[31 * 33]);
    GAS unsigned char* dp = (GAS unsigned char*)WT + (size_t)(dst_row0 + n) * ldk + k0 + kh;
    *(GAS u32x4*)dp = o0; *(GAS u32x4*)(dp + 16) = o1;
    asm volatile("s_waitcnt lgkmcnt(0)" ::: "memory");
}
DI void conv_matrix_item8(const float* W, int K, int N, unsigned char* WT, int mode, float scale, LAS float* scr, int item, int lane) {
    const int nblk = N / 32, kb = item / nblk, nb = item % nblk, src0 = nb * 32;
    conv_item8(W, N, WT, K, (mode == 2) ? ((src0 >> 7) * 256 + (src0 & 127)) : (mode == 3) ? ((src0 >> 7) * 256 + 128 + (src0 & 127)) : src0, src0, kb * 64, scale, scr, lane);
}
DI int conv_dst1(int src) {
    if (src < 672) return src;
    if (src >= 1696) return src + 96;
    const int rk = src >= 1184, rel = src - (rk ? 1184 : 672), head = rel >> 6, half = (rel >> 5) & 1, i = rel & 31;
    return (rk ? 1280 : 768) + (head >> 2) * 256 + half * 128 + (head & 3) * 32 + i;
}
DI int conv_dst(int mode, int src) { return (mode == 0 || mode == 4) ? src : mode == 1 ? conv_dst1(src) : mode == 2 ? ((src >> 7) * 256 + (src & 127)) : ((src >> 7) * 256 + 128 + (src & 127)); }
DI float conv_scale(int mode, int src) { return mode != 4 ? 1.0f : (src < 1024 ? 0.125f * LOG2E : ((src >= 1280 && src < 1792) ? 0.125f : 1.0f)); }
DI void conv_matrix_item(const float* W, int K, int N, bf16* WT, int mode, LAS float* scr, int item, int lane, const float* kgain = nullptr) {
    const int nblk = N / 32, kb = item / nblk, nb = item % nblk, src0 = nb * 32;
    conv_item(W, N, WT, K, conv_dst(mode, src0), src0, kb * 64, conv_scale(mode, src0), scr, lane, kgain);
}

DI void rms_row_to_bf16(const float* xrow, const float* g, bf16* orow, int lane) {
    const GAS f32x4* xr = (const GAS f32x4*)xrow + lane; const GAS f32x4* gr = (const GAS f32x4*)g + lane;
    f32x4 v[4]; float s = 0.f;
#pragma unroll
    for (int j = 0; j < 4; ++j) { v[j] = xr[64 * j]; s += (v[j].x * v[j].x + v[j].y * v[j].y) + (v[j].z * v[j].z + v[j].w * v[j].w); }
    const float rs = 1.0f / sqrtf(wave_sum(s) * (1.f / DM) + EPS);
    GAS u32x2* o8 = (GAS u32x2*)orow + lane;
#pragma unroll
    for (int j = 0; j < 4; ++j) { const f32x4 gg = gr[64 * j]; u32x2 o; o.x = pk2(v[j].x * rs * gg.x, v[j].y * rs * gg.y); o.y = pk2(v[j].z * rs * gg.z, v[j].w * rs * gg.w); o8[64 * j] = o; }
}
DI void rms_rows2_to_bf16(const float* x0, const float* x1, const float* g, bf16* o0, bf16* o1, int lane, float sgn = 1.0f) {
    const GAS f32x4* xr0 = (const GAS f32x4*)x0 + lane; const GAS f32x4* xr1 = (const GAS f32x4*)x1 + lane; const GAS f32x4* gr = (const GAS f32x4*)g + lane;
    f32x4 v[4], u[4];
#pragma unroll
    for (int j = 0; j < 4; ++j) { v[j] = xr0[64 * j]; u[j] = xr1[64 * j]; }
    float s = 0.f, t = 0.f;
#pragma unroll
    for (int j = 0; j < 4; ++j) { s += (v[j].x * v[j].x + v[j].y * v[j].y) + (v[j].z * v[j].z + v[j].w * v[j].w); t += (u[j].x * u[j].x + u[j].y * u[j].y) + (u[j].z * u[j].z + u[j].w * u[j].w); }
    const float rs = sgn / sqrtf(wave_sum(s) * (1.f / DM) + EPS), rt = sgn / sqrtf(wave_sum(t) * (1.f / DM) + EPS);
    GAS u32x2* p0 = (GAS u32x2*)o0 + lane; GAS u32x2* p1 = (GAS u32x2*)o1 + lane;
#pragma unroll
    for (int j = 0; j < 4; ++j) { const f32x4 gg = gr[64 * j]; u32x2 a, b; a.x = pk2(v[j].x * rs * gg.x, v[j].y * rs * gg.y); a.y = pk2(v[j].z * rs * gg.z, v[j].w * rs * gg.w);
        b.x = pk2(u[j].x * rt * gg.x, u[j].y * rt * gg.y); b.y = pk2(u[j].z * rt * gg.z, u[j].w * rt * gg.w); p0[64 * j] = a; p1[64 * j] = b; }
}
DI void rows2_to_bf16_ssq(const float* x0, const float* x1, bf16* o0, bf16* o1, float* q0, float* q1, int lane, float sgn = 1.0f) {
    const GAS f32x4* xr0 = (const GAS f32x4*)x0 + lane; const GAS f32x4* xr1 = (const GAS f32x4*)x1 + lane;
    f32x4 v[4], u[4];
#pragma unroll
    for (int j = 0; j < 4; ++j) { v[j] = __builtin_nontemporal_load(xr0 + 64 * j); u[j] = __builtin_nontemporal_load(xr1 + 64 * j); }
    GAS u32x2* p0 = (GAS u32x2*)o0 + lane; GAS u32x2* p1 = (GAS u32x2*)o1 + lane;
    float s = 0.f, t = 0.f;
#pragma unroll
    for (int j = 0; j < 4; ++j) { u32x2 a, b; a.x = pk2(v[j].x * sgn, v[j].y * sgn); a.y = pk2(v[j].z * sgn, v[j].w * sgn); b.x = pk2(u[j].x * sgn, u[j].y * sgn); b.y = pk2(u[j].z * sgn, u[j].w * sgn); p0[64 * j] = a; p1[64 * j] = b;
        const float a0 = bf_lo(a.x), a1 = bf_hi(a.x), a2 = bf_lo(a.y), a3 = bf_hi(a.y), b0 = bf_lo(b.x), b1 = bf_hi(b.x), b2 = bf_lo(b.y), b3 = bf_hi(b.y);
        s += (a0 * a0 + a1 * a1) + (a2 * a2 + a3 * a3); t += (b0 * b0 + b1 * b1) + (b2 * b2 + b3 * b3); }
    s = wave_sum(s); t = wave_sum(t);
    if (lane == 0) { *q0 = 0.25f * s; *q1 = 0.25f * t; }
}
DI void rms_row_to_fp8(const float* xrow, const float* g, unsigned char* orow, int lane) {
    const GAS f32x4* xr = (const GAS f32x4*)xrow + lane; const GAS f32x4* gr = (const GAS f32x4*)g + lane;
    f32x4 v[4]; float s = 0.f;
#pragma unroll
    for (int j = 0; j < 4; ++j) { v[j] = xr[64 * j]; s += (v[j].x * v[j].x + v[j].y * v[j].y) + (v[j].z * v[j].z + v[j].w * v[j].w); }
    const float rs = 1.0f / sqrtf(wave_sum(s) * (1.f / DM) + EPS);
    GAS unsigned* o4 = (GAS unsigned*)orow + lane;
#pragma unroll
    for (int j = 0; j < 4; ++j) { const f32x4 gg = gr[64 * j]; o4[64 * j] = pk4_fp8(v[j].x * rs * gg.x, v[j].y * rs * gg.y, v[j].z * rs * gg.z, v[j].w * rs * gg.w); }
}
}
namespace fk {
#define MFMA32(a, b, c) __builtin_amdgcn_mfma_f32_32x32x16_bf16((a), (b), (c), 0, 0, 0)
DI int crow(int i, int h) { return (i & 3) + 8 * (i >> 2) + 4 * h; }
DI int kvpos(int kv) { return (kv & ~12) | ((kv & 4) << 1) | ((kv & 8) >> 1); }
template <int S> DI bf16x8 pack8(const f32x16& x) { u32x4 p; p.x = pk2(x[8 * S], x[8 * S + 1]); p.y = pk2(x[8 * S + 2], x[8 * S + 3]); p.z = pk2(x[8 * S + 4], x[8 * S + 5]); p.w = pk2(x[8 * S + 6], x[8 * S + 7]); return __builtin_bit_cast(bf16x8, p); }
DI f32x16 zero16() { f32x16 z;
#pragma unroll
    for (int i = 0; i < 16; ++i) z[i] = 0.f;
    return z; }
DI float ex2(float x) { return __builtin_amdgcn_exp2f(x); }

template <int NST> DI void qk_tile(const LAS unsigned char* Kb, int kstr, const bf16x8* qf, f32x16& p0, f32x16& p1, int r, int hh) {
    p0 = zero16(); p1 = zero16();
    const LAS unsigned char* k0p = Kb + r * kstr + hh * 16; const LAS unsigned char* k1p = k0p + 32 * kstr;
#pragma unroll
    for (int st = 0; st < NST; ++st) { const bf16x8 a0 = *(const LAS bf16x8*)(k0p + st * 32); const bf16x8 a1 = *(const LAS bf16x8*)(k1p + st * 32);
        p0 = MFMA32(a0, qf[st], p0); p1 = MFMA32(a1, qf[st], p1); }
}
typedef short v4i16_t __attribute__((ext_vector_type(4)));
DI bf16x8 tr_frag(const LAS unsigned char* p, int hi_off) {
    const v4i16_t lo = __builtin_amdgcn_ds_read_tr16_b64_v4i16((LAS v4i16_t*)p), hi = __builtin_amdgcn_ds_read_tr16_b64_v4i16((LAS v4i16_t*)(p + hi_off));
    return (bf16x8){lo[0], lo[1], lo[2], lo[3], hi[0], hi[1], hi[2], hi[3]};
}
DI int tr_lane_off(int lane, int stride, int hh_mul) { const int i = lane & 15, q = i >> 2, pp = i & 3, g1 = (lane >> 4) & 1, hh = lane >> 5; return (hh_mul * hh + q) * stride + (16 * g1 + 4 * pp) * 2; }
template <int NDB> DI void pv_tile(const LAS unsigned char* Vb, int vstr, const f32x16& p0, const f32x16& p1, f32x16* o, int lane) {
    const LAS unsigned char* vp = Vb + tr_lane_off(lane, vstr, 4);
#define FK_PVSTEP(P, A, S) { const bf16x8 pp = pack8<S>(P); _Pragma("unroll") for (int db = 0; db < NDB; ++db) { \
        const bf16x8 vf = tr_frag(vp + (32 * (A) + 16 * (S)) * vstr + db * 64, 8 * vstr); o[db] = MFMA32(vf, pp, o[db]); } }
    FK_PVSTEP(p0, 0, 0) FK_PVSTEP(p0, 0, 1) FK_PVSTEP(p1, 1, 0) FK_PVSTEP(p1, 1, 1)
#undef FK_PVSTEP
}
template <int NDB> DI void softmax_step(f32x16& p0, f32x16& p1, float& m, float& l, f32x16* o) {
    float mx = p0[0];
#pragma unroll
    for (int i = 1; i < 16; ++i) mx = fmaxf(mx, p0[i]);
#pragma unroll
    for (int i = 0; i < 16; ++i) mx = fmaxf(mx, p1[i]);
    mx = fmaxf(mx, __shfl_xor(mx, 32));
    const float mn = fmaxf(m, mx); const float alpha = ex2(m - mn); float s = 0.f;
#pragma unroll
    for (int i = 0; i < 16; ++i) { p0[i] = ex2(p0[i] - mn); s += p0[i]; }
#pragma unroll
    for (int i = 0; i < 16; ++i) { p1[i] = ex2(p1[i] - mn); s += p1[i]; }
    l = l * alpha + s; m = mn;
#pragma unroll
    for (int db = 0; db < NDB; ++db) o[db] *= alpha;
}
template <int NST> DI void qk_half(const LAS unsigned char* Kb, int kstr, const bf16x8* qf, f32x16& p0, int r, int hh) {
    p0 = zero16(); const LAS unsigned char* k0p = Kb + r * kstr + hh * 16;
#pragma unroll
    for (int st = 0; st < NST; ++st) { const bf16x8 a0 = *(const LAS bf16x8*)(k0p + st * 32); p0 = MFMA32(a0, qf[st], p0); }
}
template <int NDB> DI void softmax_half(f32x16& p0, float& m, float& l, f32x16* o) {
    float mx = p0[0];
#pragma unroll
    for (int i = 1; i < 16; ++i) mx = fmaxf(mx, p0[i]);
    mx = fmaxf(mx, __shfl_xor(mx, 32));
    const float mn = fmaxf(m, mx); const float alpha = ex2(m - mn); float s = 0.f;
#pragma unroll
    for (int i = 0; i < 16; ++i) { p0[i] = ex2(p0[i] - mn); s += p0[i]; }
    l = l * alpha + s; m = mn;
#pragma unroll
    for (int db = 0; db < NDB; ++db) o[db] *= alpha;
}
template <int NDB> DI void pv_half(const LAS unsigned char* Vb, int vstr, const f32x16& p0, f32x16* o, int lane) {
    const LAS unsigned char* vp = Vb + tr_lane_off(lane, vstr, 4);
    { const bf16x8 pp = pack8<0>(p0);
#pragma unroll
      for (int db = 0; db < NDB; ++db) { const bf16x8 vf = tr_frag(vp + db * 64, 8 * vstr); o[db] = MFMA32(vf, pp, o[db]); } }
    { const bf16x8 pp = pack8<1>(p0);
#pragma unroll
      for (int db = 0; db < NDB; ++db) { const bf16x8 vf = tr_frag(vp + 16 * vstr + db * 64, 8 * vstr); o[db] = MFMA32(vf, pp, o[db]); } }
}
DI void store_o64(bf16* orow, const f32x16* o, float sc, int hh) {
#pragma unroll
    for (int db = 0; db < 2; ++db)
#pragma unroll
        for (int g4 = 0; g4 < 4; ++g4) { u32x2 w; w.x = pk2(o[db][4 * g4] * sc, o[db][4 * g4 + 1] * sc); w.y = pk2(o[db][4 * g4 + 2] * sc, o[db][4 * g4 + 3] * sc);
            *(u32x2*)(orow + 32 * db + 8 * g4 + 4 * hh) = w; }
}
template <bool F8> DI void store_mix64(bf16* MIXB, size_t tok, int col, const f32x16* o, float sc, int hh) {
    if constexpr (F8) {
    unsigned char* orow = (unsigned char*)MIXB + tok * 1536 + col; const float s16 = sc * MIX_SCALE;
#pragma unroll
    for (int db = 0; db < 2; ++db)
#pragma unroll
        for (int g4 = 0; g4 < 4; ++g4) *(unsigned*)(orow + 32 * db + 8 * g4 + 4 * hh) = pk4_fp8(o[db][4 * g4] * s16, o[db][4 * g4 + 1] * s16, o[db][4 * g4 + 2] * s16, o[db][4 * g4 + 3] * s16);
    } else store_o64(MIXB + tok * 1536 + col, o, sc, hh);
}
DI void tr_write8(LAS unsigned char* img, int stride, int row0, int pos, const u32x4& v) {
#pragma unroll
    for (int e = 0; e < 8; ++e) *(LAS unsigned short*)(img + (row0 + e) * stride + pos * 2) = (unsigned short)(v[e >> 1] >> (16 * (e & 1)));
}

DI void lds_barrier() { asm volatile("s_waitcnt lgkmcnt(0)" ::: "memory"); __builtin_amdgcn_s_barrier(); asm volatile("" ::: "memory"); }
DI int queue_first(Frame& F, int q) {
    __syncthreads();
    if ((F.wave * 64 + lane_id()) == 0) F.MISC[16] = __hip_atomic_fetch_add(F.ctl + CW_QUEUE + 64 * q, 1u, RLX_AGENT);
    __syncthreads();
    return (int)F.MISC[16];
}
#ifndef QUEUE_LOOKAHEAD
#define QUEUE_LOOKAHEAD 0
#endif
DI unsigned queue_post(Frame& F, int q) {
    if (!QUEUE_LOOKAHEAD) return 0u;
    unsigned v = 0u;
    if ((F.wave * 64 + lane_id()) == 0) v = __hip_atomic_fetch_add(F.ctl + CW_QUEUE + 64 * q, 1u, RLX_AGENT);
    return v;
}
DI int queue_take(Frame& F, unsigned v, int q) {
    if (!QUEUE_LOOKAHEAD) return queue_first(F, q);
    if ((F.wave * 64 + lane_id()) == 0) F.MISC[17] = v;
    __syncthreads();
    const int r = (int)F.MISC[17];
    __syncthreads();
    return r;
}

template <int NR> DI void p_post_rows(bf16* const (&Prow)[NR], const int (&pos)[NR], const float* qn, const float* kvn, const float2* cs16, int lane) {
    u32x4 vq[NR], vkv[NR]; unsigned kr1[NR], kr2[NR]; float2 t16[NR];
#pragma unroll
    for (int x = 0; x < NR; ++x) {
        vq[x] = (u32x4){0u, 0u, 0u, 0u}; if (lane < 48) vq[x] = *(const u32x4*)(Prow[x] + PC_QLAT + lane * 8);
        vkv[x] = (u32x4){0u, 0u, 0u, 0u}; if (lane < 32) vkv[x] = *(const u32x4*)(Prow[x] + PC_KVLAT + lane * 8);
        kr1[x] = 0u; kr2[x] = 0u; t16[x] = make_float2(1.f, 0.f);
        if (lane < 16) { kr1[x] = (unsigned)Prow[x][PC_KROPE + lane]; kr2[x] = (unsigned)Prow[x][PC_KROPE + 16 + lane]; t16[x] = cs16[pos[x] * 16 + lane]; }
    }
    f32x4 gq0 = (f32x4){0.f, 0.f, 0.f, 0.f}, gq1 = gq0, gk0 = gq0, gk1 = gq0;
    if (lane < 48) { gq0 = *(const f32x4*)(qn + lane * 8); gq1 = *(const f32x4*)(qn + lane * 8 + 4); }
    if (lane < 32) { gk0 = *(const f32x4*)(kvn + lane * 8); gk1 = *(const f32x4*)(kvn + lane * 8 + 4); }
#pragma unroll
    for (int x = 0; x < NR; ++x) {
        {   float f[8];
#pragma unroll
            for (int j = 0; j < 4; ++j) { f[2 * j] = bf_lo(vq[x][j]); f[2 * j + 1] = bf_hi(vq[x][j]); }
            float ss = 0.f;
#pragma unroll
            for (int j = 0; j < 8; ++j) ss += f[j] * f[j];
            const float rs = 1.0f / sqrtf(wave_sum(ss) * (1.0f / 384.0f) + EPS);
            if (lane < 48) { u32x4 w; w.x = pk2(f[0] * rs * gq0[0], f[1] * rs * gq0[1]); w.y = pk2(f[2] * rs * gq0[2], f[3] * rs * gq0[3]); w.z = pk2(f[4] * rs * gq1[0], f[5] * rs * gq1[1]); w.w = pk2(f[6] * rs * gq1[2], f[7] * rs * gq1[3]);
                *(u32x4*)(Prow[x] + PC_QLAT + lane * 8) = w; } }
        {   float f[8];
#pragma unroll
            for (int j = 0; j < 4; ++j) { f[2 * j] = bf_lo(vkv[x][j]); f[2 * j + 1] = bf_hi(vkv[x][j]); }
            float ss = 0.f;
#pragma unroll
            for (int j = 0; j < 8; ++j) ss += f[j] * f[j];
            const float rs = 1.0f / sqrtf(wave_sum(ss) * (1.0f / 256.0f) + EPS);
            if (lane < 32) { u32x4 w; w.x = pk2(f[0] * rs * gk0[0], f[1] * rs * gk0[1]); w.y = pk2(f[2] * rs * gk0[2], f[3] * rs * gk0[3]); w.z = pk2(f[4] * rs * gk1[0], f[5] * rs * gk1[1]); w.w = pk2(f[6] * rs * gk1[2], f[7] * rs * gk1[3]);
                *(u32x4*)(Prow[x] + PC_KVLAT + lane * 8) = w; } }
        if (lane < 16) { const float x1 = bf_lo(kr1[x]), x2 = bf_lo(kr2[x]); const float2 t = t16[x];
            const unsigned o = pk2(x1 * t.x - x2 * t.y, x1 * t.y + x2 * t.x);
            Prow[x][PC_KROPE + lane] = (bf16)(o & 0xffffu); Prow[x][PC_KROPE + 16 + lane] = (bf16)(o >> 16); }
    }
}

#ifndef MLA_PIPE
#define MLA_PIPE 0
#endif
#ifndef MLA_PINGPONG
#define MLA_PINGPONG 0
#endif
constexpr int MLA_KSTR = 208, MLA_VSTR = 192, MLA_KBUF = 64 * MLA_KSTR, MLA_VBUF = 64 * MLA_VSTR, MLA_V0 = 2 * MLA_KBUF;
DI void mla_unit(Frame& F, int b, int h, int qb, const bf16* Q, const bf16* KVH, const bf16* P, bf16* MIX) {
    const int tid = (F.wave * 64 + lane_id()), lane = tid & 63, w = F.wave, r = lane & 31, hh = lane >> 5;
    const int q0 = qb * 256, qw0 = q0 + 32 * w; const size_t tokb = (size_t)b * SEQ;
    bf16x8 qf[6];
    { const bf16* qp = Q + (tokb + qw0 + r) * 768 + h * 96 + 8 * hh;
#pragma unroll
      for (int st = 0; st < 6; ++st) qf[st] = *(const bf16x8*)(qp + 16 * st); }
    const bf16* ksrc = KVH + (tokb + (tid >> 3)) * 1024 + h * 128 + (tid & 7) * 8;
    const bf16* pesrc = P + (tokb + (tid >> 2)) * AB_P + PC_KROPE + (tid & 3) * 8;
    const bf16* vsrc = ksrc + 64;
    const int kdst = (tid >> 3) * MLA_KSTR + (tid & 7) * 16, pedst = (tid >> 2) * MLA_KSTR + 128 + (tid & 3) * 16, vdst = (tid >> 3) * MLA_VSTR + (tid & 7) * 16;
    const int nt = 4 * (qb + 1);
    u32x4 kreg, pereg = (u32x4){0u, 0u, 0u, 0u}, vreg;
    kreg = *(const u32x4*)ksrc; if (tid < 256) pereg = *(const u32x4*)pesrc; vreg = *(const u32x4*)vsrc;
    float m = -INFINITY, l = 0.f; f32x16 o[2]; o[0] = zero16(); o[1] = zero16();
#if MLA_PIPE
    constexpr int KB3 = MLA_KBUF, VB3 = MLA_VBUF, V03 = 3 * MLA_KBUF;
    u32x4 kreg2 = kreg, pereg2 = pereg, vreg2 = vreg;
    if (nt > 1) { kreg2 = *(const u32x4*)(ksrc + (size_t)64 * 1024); if (tid < 256) pereg2 = *(const u32x4*)(pesrc + (size_t)64 * AB_P); vreg2 = *(const u32x4*)(vsrc + (size_t)64 * 1024); }
#define FK_MLA_STAGE3(t_) do { const int b3_ = (t_) % 3; LAS unsigned char* Kw_ = F.lds + b3_ * KB3; LAS unsigned char* Vw_ = F.lds + V03 + b3_ * VB3; \
        *(LAS u32x4*)(Kw_ + kdst) = kreg; if (tid < 256) *(LAS u32x4*)(Kw_ + pedst) = pereg; *(LAS u32x4*)(Vw_ + vdst) = vreg; \
        kreg = kreg2; pereg = pereg2; vreg = vreg2; \
        if ((t_) + 2 < nt) { kreg2 = *(const u32x4*)(ksrc + (size_t)((t_) + 2) * 64 * 1024); if (tid < 256) pereg2 = *(const u32x4*)(pesrc + (size_t)((t_) + 2) * 64 * AB_P); vreg2 = *(const u32x4*)(vsrc + (size_t)((t_) + 2) * 64 * 1024); } } while (0)
#define FK_MLA_QK(t_, P0, P1) do { qk_tile<6>(F.lds + ((t_) % 3) * KB3, MLA_KSTR, qf, P0, P1, r, hh); \
        if (64 * (t_) + 63 > qw0) { const int qg_ = qw0 + r; _Pragma("unroll") for (int i = 0; i < 16; ++i) { const int kv = 64 * (t_) + crow(i, hh); if (kv > qg_) P0[i] = -INFINITY; if (kv + 32 > qg_) P1[i] = -INFINITY; } } } while (0)
    f32x16 p0 = zero16(), p1 = zero16();
    FK_MLA_STAGE3(0);
    lds_barrier();
    FK_MLA_QK(0, p0, p1);
    for (int t = 0; t < nt; ++t) {
        if (t + 1 < nt) FK_MLA_STAGE3(t + 1);
        lds_barrier();
        const bool need = 64 * t <= qw0 + 31, need_next = (t + 1 < nt) && (64 * (t + 1) <= qw0 + 31);
        f32x16 n0 = zero16(), n1 = zero16();
        if (need_next) FK_MLA_QK(t + 1, n0, n1);
        if (need) { softmax_step<2>(p0, p1, m, l, o); pv_tile<2>(F.lds + V03 + (t % 3) * VB3, MLA_VSTR, p0, p1, o, lane); }
        p0 = n0; p1 = n1;
    }
#undef FK_MLA_STAGE3
#undef FK_MLA_QK
#elif MLA_PINGPONG
    const int half = w >> 2;
    f32x16 p0 = zero16(), p1 = zero16();
    u32x4 kreg2 = kreg, pereg2 = pereg, vreg2 = vreg;
    if (nt > 1) { kreg2 = *(const u32x4*)(ksrc + (size_t)64 * 1024); if (tid < 256) pereg2 = *(const u32x4*)(pesrc + (size_t)64 * AB_P); vreg2 = *(const u32x4*)(vsrc + (size_t)64 * 1024); }
#define FK_MLA_STAGE(t_) do { LAS unsigned char* Kw_ = F.lds + ((t_) & 1) * MLA_KBUF; LAS unsigned char* Vw_ = F.lds + MLA_V0 + ((t_) & 1) * MLA_VBUF; \
        *(LAS u32x4*)(Kw_ + kdst) = kreg; if (tid < 256) *(LAS u32x4*)(Kw_ + pedst) = pereg; *(LAS u32x4*)(Vw_ + vdst) = vreg; \
        kreg = kreg2; pereg = pereg2; vreg = vreg2; \
        if ((t_) + 2 < nt) { kreg2 = *(const u32x4*)(ksrc + (size_t)((t_) + 2) * 64 * 1024); if (tid < 256) pereg2 = *(const u32x4*)(pesrc + (size_t)((t_) + 2) * 64 * AB_P); vreg2 = *(const u32x4*)(vsrc + (size_t)((t_) + 2) * 64 * 1024); } } while (0)
    FK_MLA_STAGE(0);
    for (int s2 = 0; s2 <= 2 * nt; ++s2) {
        lds_barrier();
        const int ph = s2 - half;
        if (ph < 0 || ph >= 2 * nt) continue;
        const int t = ph >> 1; const bool need = 64 * t <= qw0 + 31;
        LAS unsigned char* Kb = F.lds + (t & 1) * MLA_KBUF; LAS unsigned char* Vb = F.lds + MLA_V0 + (t & 1) * MLA_VBUF;
        if (!(ph & 1)) {
            if (half == 1 && t + 1 < nt) FK_MLA_STAGE(t + 1);
            if (need) { qk_tile<6>(Kb, MLA_KSTR, qf, p0, p1, r, hh);
                if (64 * t + 63 > qw0) { const int qg = qw0 + r;
#pragma unroll
                    for (int i = 0; i < 16; ++i) { const int kv = 64 * t + crow(i, hh); if (kv > qg) p0[i] = -INFINITY; if (kv + 32 > qg) p1[i] = -INFINITY; } } }
        } else {
            if (need) { softmax_step<2>(p0, p1, m, l, o); pv_tile<2>(Vb, MLA_VSTR, p0, p1, o, lane); }
            if (half == 0 && t + 1 < nt) FK_MLA_STAGE(t + 1);
        }
    }
#undef FK_MLA_STAGE
#else
    u32x4 kreg2 = kreg, pereg2 = pereg, vreg2 = vreg;
    if (nt > 1) { kreg2 = *(const u32x4*)(ksrc + (size_t)64 * 1024); if (tid < 256) pereg2 = *(const u32x4*)(pesrc + (size_t)64 * AB_P); vreg2 = *(const u32x4*)(vsrc + (size_t)64 * 1024); }
    for (int t = 0; t < nt; ++t) {
        LAS unsigned char* Kb = F.lds + (t & 1) * MLA_KBUF; LAS unsigned char* Vb = F.lds + MLA_V0 + (t & 1) * MLA_VBUF;
        *(LAS u32x4*)(Kb + kdst) = kreg; if (tid < 256) *(LAS u32x4*)(Kb + pedst) = pereg; *(LAS u32x4*)(Vb + vdst) = vreg;
        lds_barrier();
        kreg = kreg2; pereg = pereg2; vreg = vreg2;
        if (t + 2 < nt) { kreg2 = *(const u32x4*)(ksrc + (size_t)(t + 2) * 64 * 1024); if (tid < 256) pereg2 = *(const u32x4*)(pesrc + (size_t)(t + 2) * 64 * AB_P); vreg2 = *(const u32x4*)(vsrc + (size_t)(t + 2) * 64 * 1024); }
        if (64 * t <= qw0 + 31) {
            f32x16 p0, p1; qk_tile<6>(Kb, MLA_KSTR, qf, p0, p1, r, hh);
            if (64 * t + 63 > qw0) { const int qg = qw0 + r;
#pragma unroll
                for (int i = 0; i < 16; ++i) { const int kv = 64 * t + crow(i, hh); if (kv > qg) p0[i] = -INFINITY; if (kv + 32 > qg) p1[i] = -INFINITY; } }
            softmax_step<2>(p0, p1, m, l, o);
            pv_tile<2>(Vb, MLA_VSTR, p0, p1, o, lane);
        }
    }
#endif
    l += __shfl_xor(l, 32);
    store_mix64<OUTPROJ_FP8 != 0>(MIX, tokb + qw0 + r, h * 64, o, 1.0f / l, hh);
}

constexpr int RT_KS = 0, RT_KT = 18432, RT_VT = 43008, RT_ST = 83968, RT_RED = 102400, RT_KRS = 192, RT_VS = 320;
DI void ret_unit(Frame& F, int b, int h, const bf16* P, const float* gn, bf16* MIX) {
    const int lane = (F.wave * 64 + lane_id()) & 63, w = F.wave, r = lane & 31, hh = lane >> 5;
    const int vh = w >> 2, qg = vh ? 3 - (w & 3) : (w & 3);
    const int dvb = w & 3, db2 = w >> 2;
    const size_t tokb = (size_t)b * SEQ;
    const float lg2 = log1pf(-ex2(-5.0f - (float)h)) * LOG2E;
    const float gam = ex2(lg2), g127 = ex2(127.0f * lg2), g128 = ex2(128.0f * lg2);
    LAS unsigned char* Ks = F.lds + RT_KS; LAS unsigned char* Kt = F.lds + RT_KT; LAS unsigned char* Vt = F.lds + RT_VT; LAS unsigned char* St = F.lds + RT_ST;
    LAS f32x2_t* red = (LAS f32x2_t*)(F.lds + RT_RED);
    f32x16 st = zero16();
    LAS float* gnl = (LAS float*)(F.lds + RT_RED + 2048);
    { const int t_ = F.wave * 64 + lane; if (t_ < 128) gnl[t_] = gn[h * 128 + t_]; }
    u32x4 kreg[2], vreg[4]; bf16x8 qf[4];
    const int tid = F.wave * 64 + lane;
#define FK_RET_LOAD(n_) do { const size_t tok0_ = tokb + (size_t)(n_) * 128; \
        _Pragma("unroll") for (int it = 0; it < 2; ++it) { const int c = tid + 512 * it; kreg[it] = *(const u32x4*)(P + (tok0_ + (c >> 3)) * AB_P + PC_RK + h * 64 + (c & 7) * 8); } \
        _Pragma("unroll") for (int it = 0; it < 4; ++it) { const int c = tid + 512 * it; vreg[it] = *(const u32x4*)(P + (tok0_ + (c >> 4)) * AB_P + PC_RV + h * 128 + (c & 15) * 8); } \
        const bf16* qp = P + (tok0_ + 32 * qg + r) * AB_P + PC_RQ + h * 64 + 8 * hh; _Pragma("unroll") for (int s4 = 0; s4 < 4; ++s4) qf[s4] = *(const bf16x8*)(qp + 16 * s4); } while (0)
    FK_RET_LOAD(0);
    for (int n = 0; n < 16; ++n) {
        const size_t tok0 = tokb + (size_t)n * 128;
#ifdef PROBE_RETSEG
        unsigned long long _rs0 = __builtin_amdgcn_s_memrealtime();
#endif
        lds_barrier();
#pragma unroll
        for (int i = 0; i < 16; ++i) *(LAS unsigned short*)(St + (32 * dvb + crow(i, hh)) * 144 + (32 * db2 + r) * 2) = (unsigned short)(pk2(st[i] * gam, 0.f) & 0xffffu);
#pragma unroll
        for (int it = 0; it < 2; ++it) { const int c = tid + 512 * it; *(LAS u32x4*)(Ks + (c >> 3) * 144 + (c & 7) * 16) = kreg[it]; *(LAS u32x4*)(Kt + (c >> 3) * RT_KRS + (c & 7) * 16) = kreg[it]; }
#pragma unroll
        for (int it = 0; it < 4; ++it) { const int c = tid + 512 * it; *(LAS u32x4*)(Vt + (c >> 4) * RT_VS + (c & 15) * 16) = vreg[it]; }
        bf16x8 qc[4];
#pragma unroll
        for (int s4 = 0; s4 < 4; ++s4) qc[s4] = qf[s4];
        lds_barrier();
#ifdef PROBE_RETSEG
        unsigned long long _rs1 = __builtin_amdgcn_s_memrealtime();
#endif
        if (n + 1 < 16) FK_RET_LOAD(n + 1);
        const size_t tok = tok0 + 32 * qg + r; const bf16* rgp = P + tok * AB_P + PC_RG + h * 128 + 64 * vh;
        u32x2 gv[2][4];
#pragma unroll
        for (int db = 0; db < 2; ++db)
#pragma unroll
            for (int g4 = 0; g4 < 4; ++g4) gv[db][g4] = *(const u32x2*)(rgp + 32 * db + 8 * g4 + 4 * hh);
        f32x16 o[2]; o[0] = zero16(); o[1] = zero16();
        const int ntile = (qg >> 1) + 1;
        for (int kt = 0; kt < ntile; ++kt) {
            f32x16 p0, p1; qk_tile<4>(Ks + kt * 64 * 144, 144, qc, p0, p1, r, hh);
            if (kt == (qg >> 1)) { const int ql = 32 * qg + r;
#pragma unroll
                for (int i = 0; i < 16; ++i) { const int kv = 64 * kt + crow(i, hh); if (kv > ql) p0[i] = 0.f; if (kv + 32 > ql) p1[i] = 0.f; } }
            pv_tile<2>(Vt + 64 * kt * RT_VS + 64 * vh * 2, RT_VS, p0, p1, o, lane);
        }
#ifdef PROBE_RETSEG
        asm volatile("s_nop 0" :: "v"(o[0][0]), "v"(o[1][0])); const unsigned long long _rt1 = __builtin_amdgcn_s_memrealtime();
#endif
#pragma unroll
        for (int s4 = 0; s4 < 4; ++s4)
#pragma unroll
            for (int db = 0; db < 2; ++db) { const bf16x8 sf = *(const LAS bf16x8*)(St + (64 * vh + 32 * db + r) * 144 + (16 * s4 + 8 * hh) * 2); o[db] = MFMA32(sf, qc[s4], o[db]); }
#ifdef PROBE_RETSEG
        asm volatile("s_nop 0" :: "v"(o[0][0]), "v"(o[1][0])); const unsigned long long _rt2 = __builtin_amdgcn_s_memrealtime();
#endif
        float s1 = 0.f, s2 = 0.f;
#pragma unroll
        for (int db = 0; db < 2; ++db)
#pragma unroll
            for (int i = 0; i < 16; ++i) { s1 += o[db][i]; s2 += o[db][i] * o[db][i]; }
        s1 += __shfl_xor(s1, 32); s2 += __shfl_xor(s2, 32);
        if (hh == 0) red[(32 * qg + r) * 2 + vh] = (f32x2_t){s1, s2};
#ifdef PROBE_RETSEG
        const unsigned long long _rt3 = __builtin_amdgcn_s_memrealtime();
#endif
        {
            f32x16 acc = zero16();
#pragma unroll
            for (int s8 = 0; s8 < 8; ++s8) { const bf16x8 vf = tr_frag(Vt + tr_lane_off(lane, RT_VS, 8) + 16 * s8 * RT_VS + 32 * dvb * 2, 4 * RT_VS);
                const bf16x8 kf = tr_frag(Kt + tr_lane_off(lane, RT_KRS, 8) + 16 * s8 * RT_KRS + 32 * db2 * 2, 4 * RT_KRS);
                acc = MFMA32(vf, kf, acc); }
            st = st * g128 + acc * g127;
        }
#ifdef PROBE_RETSEG
        asm volatile("s_nop 0" :: "v"(st[0]));
#endif
#ifdef PROBE_RETSEG
        unsigned long long _rs2 = __builtin_amdgcn_s_memrealtime();
#endif
        lds_barrier();
#ifdef PROBE_RETSEG
        unsigned long long _rs3 = __builtin_amdgcn_s_memrealtime();
#endif
        const f32x2_t ra = red[(32 * qg + r) * 2], rb = red[(32 * qg + r) * 2 + 1];
        const float mu = (ra.x + rb.x) * (1.0f / 128.0f); const float var = (ra.y + rb.y) * (1.0f / 128.0f) - mu * mu; const float rs = 1.0f / sqrtf(var + EPS);
#if !OUTPROJ_FP8
        bf16* op = MIX + tok * 1536 + 512 + h * 128 + 64 * vh;
#endif
#pragma unroll
        for (int db = 0; db < 2; ++db)
#pragma unroll
            for (int g4 = 0; g4 < 4; ++g4) { const int dv = 32 * db + 8 * g4 + 4 * hh; const u32x2 gvv = gv[db][g4]; const f32x4 gg = *(const LAS f32x4*)(gnl + 64 * vh + dv);
                const float g0 = bf_lo(gvv.x), g1 = bf_hi(gvv.x), g2 = bf_lo(gvv.y), g3 = bf_hi(gvv.y);
                const float y0 = silu_f(g0) * ((o[db][4 * g4] - mu) * rs * gg[0]), y1 = silu_f(g1) * ((o[db][4 * g4 + 1] - mu) * rs * gg[1]);
                const float y2 = silu_f(g2) * ((o[db][4 * g4 + 2] - mu) * rs * gg[2]), y3 = silu_f(g3) * ((o[db][4 * g4 + 3] - mu) * rs * gg[3]);
#if OUTPROJ_FP8
                *(unsigned*)((unsigned char*)MIX + tok * 1536 + 512 + h * 128 + 64 * vh + dv) = pk4_fp8(y0 * MIX_SCALE, y1 * MIX_SCALE, y2 * MIX_SCALE, y3 * MIX_SCALE);
#else
                u32x2 wv; wv.x = pk2(y0, y1); wv.y = pk2(y2, y3);
                *(u32x2*)(op + dv) = wv;
#endif
                }
    }
#undef FK_RET_LOAD
}

constexpr int SW_KS = 0, SW_VT = 36864, SW_VSTR = 192;
DI void swa_unit(Frame& F, int b, int hkv, int blk, const bf16* P2, const float* sinks, bf16* MIX2) {
    const int tid = (F.wave * 64 + lane_id()), lane = tid & 63, w = F.wave, r = lane & 31, hh = lane >> 5; const size_t tokb = (size_t)b * SEQ;
    const int kb0 = 128 * (blk - 1);
    LAS unsigned char* Ks = F.lds + SW_KS; LAS unsigned char* Vt = F.lds + SW_VT;
#pragma unroll
    for (int it = 0; it < 4; ++it) { const int c = tid + 512 * it, row = c >> 3, part = c & 7; const int key = kb0 + row;
        u32x4 v = (u32x4){0u, 0u, 0u, 0u}; if (key >= 0) v = *(const u32x4*)(P2 + (tokb + key) * CD_IN + P2_SK + hkv * 64 + part * 8);
        *(LAS u32x4*)(Ks + row * 144 + part * 16) = v; }
#pragma unroll
    for (int it = 0; it < 4; ++it) { const int c = tid + 512 * it, row = c >> 3, part = c & 7; const int key = kb0 + row;
        u32x4 v = (u32x4){0u, 0u, 0u, 0u}; if (key >= 0) v = *(const u32x4*)(P2 + (tokb + key) * CD_IN + P2_SV + hkv * 64 + part * 8);
        *(LAS u32x4*)(Vt + row * SW_VSTR + part * 16) = v; }
    __syncthreads();
    const int hq = hkv * 8 + w; const float slope2 = ex2(-8.0f * (float)(hq + 1) / 16.0f) * LOG2E, sink2 = sinks[hq] * LOG2E;
    bf16x8 qn[4];
    { const bf16* qp = P2 + (tokb + 128 * blk + r) * CD_IN + P2_SQ + hq * 64 + 8 * hh;
#pragma unroll
      for (int s4 = 0; s4 < 4; ++s4) qn[s4] = *(const bf16x8*)(qp + 16 * s4); }
    for (int j = 0; j < 4; ++j) {
        const int qrow = 128 * blk + 32 * j + r; const int qband = 128 + 32 * j + r;
        bf16x8 qf[4];
#pragma unroll
        for (int s4 = 0; s4 < 4; ++s4) qf[s4] = qn[s4];
        if (j < 3) { const bf16* qp = P2 + (tokb + qrow + 32) * CD_IN + P2_SQ + hq * 64 + 8 * hh;
#pragma unroll
            for (int s4 = 0; s4 < 4; ++s4) qn[s4] = *(const bf16x8*)(qp + 16 * s4); }
        float m = sink2, l = (hh == 0) ? 1.0f : 0.0f; f32x16 o[2]; o[0] = zero16(); o[1] = zero16();
        const int kb = 32 * j;
#pragma unroll 1
        for (int x = 0; x < 2; ++x) { const int k00 = kb + 64 * x;
            f32x16 p0, p1; qk_tile<4>(Ks + k00 * 144, 144, qf, p0, p1, r, hh);
#pragma unroll
            for (int i = 0; i < 16; ++i) { const int k0 = k00 + crow(i, hh), k1 = k0 + 32; const int d0 = qband - k0, d1 = qband - k1;
                p0[i] = (d0 >= 0 && d0 < 128 && kb0 + k0 >= 0) ? p0[i] - slope2 * (float)d0 : -INFINITY;
                p1[i] = (d1 >= 0 && d1 < 128 && kb0 + k1 >= 0) ? p1[i] - slope2 * (float)d1 : -INFINITY; }
            softmax_step<2>(p0, p1, m, l, o);
            pv_tile<2>(Vt + k00 * SW_VSTR, SW_VSTR, p0, p1, o, lane); }
        { const int k00 = kb + 128;
            f32x16 p0; qk_half<4>(Ks + k00 * 144, 144, qf, p0, r, hh);
#pragma unroll
            for (int i = 0; i < 16; ++i) { const int k0 = k00 + crow(i, hh); const int d0 = qband - k0;
                p0[i] = (d0 >= 0 && d0 < 128 && kb0 + k0 >= 0) ? p0[i] - slope2 * (float)d0 : -INFINITY; }
            softmax_half<2>(p0, m, l, o);
            pv_half<2>(Vt + k00 * SW_VSTR, SW_VSTR, p0, o, lane); }
        l += __shfl_xor(l, 32);
        store_mix64<OUTPROJ2_FP8 != 0>(MIX2, tokb + qrow, hq * 64, o, 1.0f / l, hh);
    }
}

constexpr int SB_K0 = 0, SB_V0 = 18432, SB_FLAG = 43008, SB_BUF = 9216, SB_VBUF = 12288, SB_VSTR = 192;
constexpr float SB_EXIT_MASS = 1e-20f;
DI float softplus_f(float z) { return fmaxf(z, 0.f) + 0.6931471805599453f * __builtin_amdgcn_logf(1.0f + ex2(-fabsf(z) * LOG2E)); }
DI void sb_unit(Frame& F, int b, int h, int qb, const bf16* P2, bf16* MIX2) {
    const int tid = (F.wave * 64 + lane_id()), lane = tid & 63, w = F.wave, r = lane & 31, hh = lane >> 5; const size_t tokb = (size_t)b * SEQ;
    const int q0 = qb * 256, qw0 = q0 + 32 * w, qg = qw0 + r;
    bf16x8 qf[4];
    { const bf16* qp = P2 + (tokb + qg) * CD_IN + P2_BQ + h * 64 + 8 * hh;
#pragma unroll
      for (int s4 = 0; s4 < 4; ++s4) qf[s4] = *(const bf16x8*)(qp + 16 * s4); }
    const bf16* ksrc = P2 + (tokb + (tid >> 3)) * CD_IN + P2_BK + h * 64 + (tid & 7) * 8;
    const bf16* vsrc = P2 + (tokb + (tid >> 3)) * CD_IN + P2_BV + h * 64 + (tid & 7) * 8;
    const int kdst = (tid >> 3) * 144 + (tid & 7) * 16, vdst = (tid >> 3) * SB_VSTR + (tid & 7) * 16;
    LAS unsigned* flags = (LAS unsigned*)(F.lds + SB_FLAG);
    const int tmax = 4 * qb + 3;
    u32x4 kreg = *(const u32x4*)(ksrc + (size_t)tmax * 64 * CD_IN), vreg = *(const u32x4*)(vsrc + (size_t)tmax * 64 * CD_IN);
    u32x4 kreg1 = kreg, vreg1 = vreg, kreg2 = kreg, vreg2 = vreg;
    if (tmax >= 1) { kreg1 = *(const u32x4*)(ksrc + (size_t)(tmax - 1) * 64 * CD_IN); vreg1 = *(const u32x4*)(vsrc + (size_t)(tmax - 1) * 64 * CD_IN); }
    if (tmax >= 2) { kreg2 = *(const u32x4*)(ksrc + (size_t)(tmax - 2) * 64 * CD_IN); vreg2 = *(const u32x4*)(vsrc + (size_t)(tmax - 2) * 64 * CD_IN); }
    float prun = 1.0f; bool wdone = false; f32x16 o[2]; o[0] = zero16(); o[1] = zero16();
    int it = 0;
    for (int t = tmax; t >= 0; --t, ++it) {
        LAS unsigned char* Kb = F.lds + SB_K0 + (it & 1) * SB_BUF; LAS unsigned char* Vb = F.lds + SB_V0 + (it & 1) * SB_VBUF;
        *(LAS u32x4*)(Kb + kdst) = kreg; *(LAS u32x4*)(Vb + vdst) = vreg;
        if (lane == 0) flags[(it & 1) * 8 + w] = wdone ? 1u : 0u;
        lds_barrier();
        unsigned alld = 1u;
#pragma unroll
        for (int x = 0; x < 8; ++x) alld &= flags[(it & 1) * 8 + x];
        if (alld) break;
        kreg = kreg1; vreg = vreg1; kreg1 = kreg2; vreg1 = vreg2;
        if (t > 2) { kreg2 = *(const u32x4*)(ksrc + (size_t)(t - 3) * 64 * CD_IN); vreg2 = *(const u32x4*)(vsrc + (size_t)(t - 3) * 64 * CD_IN); }
        if (64 * t <= qw0 + 30 && !wdone) {
            f32x16 z0, z1; qk_tile<4>(Kb, 144, qf, z0, z1, r, hh);
            f32x16 u0, u1;
#pragma unroll
            for (int i = 0; i < 16; ++i) { const int kv = 64 * t + crow(i, hh);
                { const float e = ex2(fminf(z0[i], 80.f) * LOG2E); const float d = __builtin_amdgcn_rcpf(1.0f + e); const bool ok = kv < qg; u0[i] = ok ? d : 1.0f; z0[i] = ok ? e * d : 0.f; }
                { const float e = ex2(fminf(z1[i], 80.f) * LOG2E); const float d = __builtin_amdgcn_rcpf(1.0f + e); const bool ok = kv + 32 < qg; u1[i] = ok ? d : 1.0f; z1[i] = ok ? e * d : 0.f; } }
            float gp[8];
#pragma unroll
            for (int g4 = 0; g4 < 4; ++g4) { gp[g4] = (u0[4 * g4] * u0[4 * g4 + 1]) * (u0[4 * g4 + 2] * u0[4 * g4 + 3]); gp[4 + g4] = (u1[4 * g4] * u1[4 * g4 + 1]) * (u1[4 * g4 + 2] * u1[4 * g4 + 3]); }
            float above[8]; float accp = 1.0f;
#pragma unroll
            for (int gi = 7; gi >= 0; --gi) { const float oth = __shfl_xor(gp[gi], 32); above[gi] = accp * (hh == 0 ? oth : 1.0f); accp *= gp[gi] * oth; }
#pragma unroll
            for (int g4 = 0; g4 < 4; ++g4) {
                { float c = prun * above[g4];
#pragma unroll
                  for (int e = 3; e >= 0; --e) { const int i = 4 * g4 + e; const float wgt = z0[i] * c; c *= u0[i]; z0[i] = wgt; } }
                { float c = prun * above[4 + g4];
#pragma unroll
                  for (int e = 3; e >= 0; --e) { const int i = 4 * g4 + e; const float wgt = z1[i] * c; c *= u1[i]; z1[i] = wgt; } }
            }
            pv_tile<2>(Vb, SB_VSTR, z0, z1, o, lane);
            prun *= accp;
            wdone = __all(prun < SB_EXIT_MASS);
        }
    }
    store_mix64<OUTPROJ2_FP8 != 0>(MIX2, tokb + qg, 1024 + h * 64, o, 1.0f, hh);
}
}
namespace fk {
enum InIdx { I_X = 0, I_AB_NORM, I_AB_W_IN, I_Q_NORM, I_W_UQ, I_KV_NORM, I_W_UKV, I_RET_GN, I_AB_W_OUT, I_FFN_NORM, I_FFN_WG, I_FFN_WU, I_FFN_WD,
             I_CD_NORM, I_CD_W_IN, I_SINKS, I_CD_W_OUT, I_MOE_NORM, I_ROUTER, I_MOE_WG, I_MOE_WU, I_MOE_WD, I_FINAL_NORM };

DI void prologue_phase(Frame& F, const Args& A) {
    const int tid = (F.wave * 64 + lane_id()), lane = tid & 63;
    const int gt = F.bid * NTHR + tid, NGT = F.G * NTHR;
    const int gw = F.bid * NWAVES + F.wave, NGW = F.G * NWAVES;
#pragma unroll 1
    for (int stage = 0; stage < 2; ++stage) {
    if (stage == 1) {
    for (int m = gw; m < T; m += 2 * NGW) { const int m2 = m + NGW; const int s0 = A.pad ? ((m & ~(SEQ - 1)) | (SEQ - 1 - (m & (SEQ - 1)))) : m, s1 = A.pad ? ((m2 & ~(SEQ - 1)) | (SEQ - 1 - (m2 & (SEQ - 1)))) : m2;
        rows2_to_bf16_ssq(A.in[I_X] + (size_t)s0 * DM, A.in[I_X] + (size_t)s1 * DM, (bf16*)(F.ws + WS_XN) + (size_t)m * DM, (bf16*)(F.ws + WS_XN) + (size_t)(m + NGW) * DM, (float*)(F.ws + WS_SSQX) + m, (float*)(F.ws + WS_SSQX) + m + NGW, lane, A.pad ? -1.0f : 1.0f); }
    } else {
    float2* cs16 = (float2*)(F.ws + WS_CS16); float2* cs32 = (float2*)(F.ws + WS_CS32);
    for (int e = gt; e < SEQ * 48; e += NGT) {
        float sn, cs;
        if (e < SEQ * 16) { const int pos = e >> 4, i = e & 15; rope_cs(pos, i, 16, sn, cs); cs16[e] = make_float2(cs, sn); }
        else { const int e2 = e - SEQ * 16; const int pos = e2 >> 5, i = e2 & 31; rope_cs(pos, i, 32, sn, cs); cs32[e2] = make_float2(cs, sn); }
    }
    {
        const float* W = A.in[I_W_UQ]; bf16* WT = (bf16*)(F.ws + WS_W_UQ); const float sc = 0.10206207261596575f * LOG2E;
        for (int e = gt; e < 768 * 384; e += NGT) { const int n = e / 384, k = e - n * 384; int src;
            if (n < 512) src = (n >> 6) * 96 + (n & 63); else if (n < 640) { const int c = n - 512; src = (c >> 4) * 96 + 64 + (c & 15); } else { const int c = n - 640; src = (c >> 4) * 96 + 80 + (c & 15); }
            WT[e] = (bf16)(pk2(W[(size_t)k * 768 + src] * sc * A.in[I_Q_NORM][k], 0.f) & 0xffffu); }
    }
    LAS float* scr = (LAS float*)(F.lds + F.wave * 16384);
    constexpr int N_ABIN = 16 * 117, N_ABPAD = 16 * 3, N_UKV = 4 * 32;
    constexpr int NITEMS = N_ABIN + N_ABPAD + N_UKV;
    for (int it = gw; it < NITEMS; it += NGW) {
        int q = it;
        if (q < N_ABIN) { conv_matrix_item(A.in[I_AB_W_IN], 1024, AB_IN, (bf16*)(F.ws + WS_W_ABIN), 1, scr, q, lane, A.in[I_AB_NORM]); continue; } q -= N_ABIN;
        if (q < N_ABPAD) { conv_item(A.in[I_AB_W_IN], AB_IN, (bf16*)(F.ws + WS_W_ABIN), 1024, 672 + 32 * (q % 3), -1, 64 * (q / 3), 1.f, scr, lane); continue; } q -= N_ABPAD;
        conv_matrix_item(A.in[I_W_UKV], 256, 1024, (bf16*)(F.ws + WS_W_UKV), 0, scr, q, lane, A.in[I_KV_NORM]);
    }
    }
    }
}
constexpr int LC_ABOUT = 24 * 32, LC_FG = 16 * 112, LC_FD = 56 * 32, LC_CDIN = 16 * 88, LC_CDOUT = 24 * 32, LC_ITEMS = LC_ABOUT + 2 * LC_FG + LC_FD + LC_CDIN + LC_CDOUT, LC_BATCH = 32;
DI void late_conv_item(Frame& F, const Args& A, int q, LAS float* scr, int lane) {
#if OUTPROJ_FP8
    if (q < LC_ABOUT) { conv_matrix_item8(A.in[I_AB_W_OUT], 1536, 1024, F.ws + WS_W_ABOUT, 0, W8_SCALE, scr, q, lane); return; } q -= LC_ABOUT;
#else
    if (q < LC_ABOUT) { conv_matrix_item(A.in[I_AB_W_OUT], 1536, 1024, (bf16*)(F.ws + WS_W_ABOUT), 0, scr, q, lane); return; } q -= LC_ABOUT;
#endif
    if (q < LC_FG) { conv_matrix_item(A.in[I_FFN_WG], 1024, FF, (bf16*)(F.ws + WS_W_FGU), 2, scr, q, lane, A.in[I_FFN_NORM]); return; } q -= LC_FG;
    if (q < LC_FG) { conv_matrix_item(A.in[I_FFN_WU], 1024, FF, (bf16*)(F.ws + WS_W_FGU), 3, scr, q, lane, A.in[I_FFN_NORM]); return; } q -= LC_FG;
#if FFN_DOWN_FP8
    if (q < LC_FD) { conv_matrix_item8(A.in[I_FFN_WD], FF, 1024, F.ws + WS_W_FD, 0, W8_SCALE, scr, q, lane); return; } q -= LC_FD;
#else
    if (q < LC_FD) { conv_matrix_item(A.in[I_FFN_WD], FF, 1024, (bf16*)(F.ws + WS_W_FD), 0, scr, q, lane); return; } q -= LC_FD;
#endif
    if (q < LC_CDIN) { conv_matrix_item(A.in[I_CD_W_IN], 1024, CD_IN, (bf16*)(F.ws + WS_W_CDIN), 4, scr, q, lane, A.in[I_CD_NORM]); return; } q -= LC_CDIN;
#if OUTPROJ2_FP8
    conv_matrix_item8(A.in[I_CD_W_OUT], 1536, 1024, F.ws + WS_W_CDOUT, 0, W8_SCALE, scr, q, lane);
#else
    conv_matrix_item(A.in[I_CD_W_OUT], 1536, 1024, (bf16*)(F.ws + WS_W_CDOUT), 0, scr, q, lane);
#endif
}
DI void late_conv_drain(Frame& F, const Args& A) {
    const int lane = (F.wave * 64 + lane_id()) & 63; LAS float* scr = (LAS float*)(F.lds + F.wave * 16384);
    constexpr int NB = (LC_ITEMS + LC_BATCH - 1) / LC_BATCH;
    for (int bt = queue_first(F, 2); bt < NB; bt = queue_first(F, 2)) {
#pragma unroll 1
        for (int j = 0; j < LC_BATCH / NWAVES; ++j) { const int q = bt * LC_BATCH + j * NWAVES + F.wave; if (q < LC_ITEMS) late_conv_item(F, A, q, scr, lane); }
    }
}
constexpr int MC_NG = 16 * 112, MC_ND = 56 * 32, MC_PER = 2 * MC_NG + MC_ND, MC_ITEMS = NEXP * MC_PER;
#ifndef MC_TAIL_ITEMS
#define MC_TAIL_ITEMS 8192
#endif
constexpr int MC_TAIL = MC_TAIL_ITEMS;
DI void moe_conv_item(Frame& F, const Args& A, int it, LAS float* scr, int lane) {
    const int e = it / MC_PER; int q = it - e * MC_PER;
    if (q < MC_NG) { conv_matrix_item8(A.in[I_MOE_WG] + (size_t)e * 1024 * FF, 1024, FF, F.ws + WS_MOEW_GU + (size_t)e * 7168 * 1024, 2, W8_SCALE, scr, q, lane); return; } q -= MC_NG;
    if (q < MC_NG) { conv_matrix_item8(A.in[I_MOE_WU] + (size_t)e * 1024 * FF, 1024, FF, F.ws + WS_MOEW_GU + (size_t)e * 7168 * 1024, 3, W8_SCALE, scr, q, lane); return; } q -= MC_NG;
    conv_matrix_item8(A.in[I_MOE_WD] + (size_t)e * FF * 1024, FF, 1024, F.ws + WS_MOEW_D + (size_t)e * 1024 * FF, 0, W8_SCALE, scr, q, lane);
}
#ifndef MC_PIPE
#define MC_PIPE 1
#endif
struct McItem { const float* W; int N; unsigned char* WT; int ldk, dst_row0, src_col0, k0; };
DI McItem moe_conv_decode(Frame& F, const Args& A, int it) {
    McItem m; const int e = it / MC_PER; int q = it - e * MC_PER; int mode;
    if (q < MC_NG) { m.W = A.in[I_MOE_WG] + (size_t)e * 1024 * FF; m.N = FF; m.WT = F.ws + WS_MOEW_GU + (size_t)e * 7168 * 1024; m.ldk = 1024; mode = 2; }
    else if (q < 2 * MC_NG) { q -= MC_NG; m.W = A.in[I_MOE_WU] + (size_t)e * 1024 * FF; m.N = FF; m.WT = F.ws + WS_MOEW_GU + (size_t)e * 7168 * 1024; m.ldk = 1024; mode = 3; }
    else { q -= 2 * MC_NG; m.W = A.in[I_MOE_WD] + (size_t)e * FF * 1024; m.N = 1024; m.WT = F.ws + WS_MOEW_D + (size_t)e * 1024 * FF; m.ldk = FF; mode = 0; }
    const int nblk = m.N / 32, kb = q / nblk, nb = q - kb * nblk, src0 = nb * 32;
    m.src_col0 = src0; m.k0 = kb * 64; m.dst_row0 = (mode == 2) ? ((src0 >> 7) * 256 + (src0 & 127)) : (mode == 3) ? ((src0 >> 7) * 256 + 128 + (src0 & 127)) : src0;
    return m;
}
DI void moe_conv_phase(Frame& F, const Args& A) {
    const int lane = (F.wave * 64 + lane_id()) & 63;
    LAS float* scr = (LAS float*)(F.lds + F.wave * 16384);
    const int gw = F.bid * NWAVES + F.wave, NGW = F.G * NWAVES; constexpr int END = MC_ITEMS - MC_TAIL;
#if !MC_PIPE
    for (int it0 = gw; it0 < END; it0 += NGW) moe_conv_item(F, A, it0, scr, lane);
    return;
#endif
    float wa[32], wb[32];
    int it = gw;
    if (it < END) { const McItem m = moe_conv_decode(F, A, it); conv8_load(wa, m.W, m.N, m.src_col0, m.k0, lane); }
    for (; it < END; it += 2 * NGW) {
        const int it2 = it + NGW, it3 = it2 + NGW;
        if (it2 < END) { const McItem m = moe_conv_decode(F, A, it2); conv8_load(wb, m.W, m.N, m.src_col0, m.k0, lane); }
        { const McItem m = moe_conv_decode(F, A, it); conv8_store(wa, m.WT, m.ldk, m.dst_row0, m.k0, W8_SCALE, scr, lane); }
        if (it3 < END) { const McItem m = moe_conv_decode(F, A, it3); conv8_load(wa, m.W, m.N, m.src_col0, m.k0, lane); }
        if (it2 < END) { const McItem m = moe_conv_decode(F, A, it2); conv8_store(wb, m.WT, m.ldk, m.dst_row0, m.k0, W8_SCALE, scr, lane); }
    }
}
DI void moe_conv_tail_drain(Frame& F, const Args& A) {
    if (MC_TAIL == 0) return;
    const int lane = (F.wave * 64 + lane_id()) & 63; LAS float* scr = (LAS float*)(F.lds + F.wave * 16384);
    constexpr int NB = (MC_TAIL + LC_BATCH - 1) / LC_BATCH;
    for (int bt = queue_first(F, 3); bt < NB; bt = queue_first(F, 3)) {
#pragma unroll 1
        for (int j = 0; j < LC_BATCH / NWAVES; ++j) { const int q = bt * LC_BATCH + j * NWAVES + F.wave; if (q < MC_TAIL) moe_conv_item(F, A, MC_ITEMS - MC_TAIL + q, scr, lane); }
    }
}
DI void norm8_phase(Frame& F, const float* g, unsigned char* XN8) {
    const int lane = (F.wave * 64 + lane_id()) & 63;
    const int gw = F.bid * NWAVES + F.wave, NGW = F.G * NWAVES;
    for (int m = gw; m < T; m += NGW) rms_row_to_fp8(F.out + (size_t)m * DM, g, XN8 + (size_t)m * DM, lane);
}
DI void norm_phase(Frame& F, const float* g, bf16* XN) {
    const int lane = (F.wave * 64 + lane_id()) & 63;
    const int gw = F.bid * NWAVES + F.wave, NGW = F.G * NWAVES;
    for (int m = gw; m < T; m += NGW) rms_row_to_bf16(F.out + (size_t)m * DM, g, XN + (size_t)m * DM, lane);
}
DI void ppost_phase(Frame& F, const Args& A) {
    const int lane = (F.wave * 64 + lane_id()) & 63;
    const int gw = F.bid * NWAVES + F.wave, NGW = F.G * NWAVES; bf16* P = (bf16*)(F.ws + WS_P);
    for (int m = gw; m < T; m += 4 * NGW) {
        bf16* const rows[4] = {P + (size_t)m * AB_P, P + (size_t)(m + NGW) * AB_P, P + (size_t)(m + 2 * NGW) * AB_P, P + (size_t)(m + 3 * NGW) * AB_P};
        const int pos[4] = {m & (SEQ - 1), (m + NGW) & (SEQ - 1), (m + 2 * NGW) & (SEQ - 1), (m + 3 * NGW) & (SEQ - 1)};
        p_post_rows<4>(rows, pos, A.in[I_Q_NORM], A.in[I_KV_NORM], (const float2*)(F.ws + WS_CS16), lane);
    }
}
constexpr int RL_TE = 36864, RL_TG = 37888, RL_RANK = 38912, RL_CNT = 39936, RL_BASE = 39968;
DI void route_phase_a(Frame& F, const Args& A) {
    const int tid = (F.wave * 64 + lane_id()), lane = tid & 63;
    LAS float* rt = (LAS float*)F.lds; LAS int* te = (LAS int*)(F.lds + RL_TE); LAS float* tg = (LAS float*)(F.lds + RL_TG); LAS int* trank = (LAS int*)(F.lds + RL_RANK);
    LAS unsigned* lcnt = (LAS unsigned*)(F.lds + RL_CNT); LAS unsigned* lbase = (LAS unsigned*)(F.lds + RL_BASE);
    for (int i = tid; i < 8192; i += NTHR) rt[(i >> 5) * 36 + (i & 31)] = A.in[I_ROUTER][i];
    if (tid < 8) lcnt[tid] = 0u;
    __syncthreads();
    const float* g = A.in[I_MOE_NORM]; unsigned char* XN3 = (unsigned char*)F.out + XN3_OUT_OFF;
    const GAS f32x4* gr = (const GAS f32x4*)g + lane;
    u32x2 hraw[4][4];
    f32x4 ggv[4];
#pragma unroll
    for (int j = 0; j < 4; ++j) ggv[j] = gr[64 * j];
#define FK_ROUTE_LOAD(q_) do { const size_t tok0_ = (size_t)F.bid * 128 + F.wave * 16 + (q_) * 4; _Pragma("unroll") for (int t4 = 0; t4 < 4; ++t4) { \
        const GAS u32x2* xr = (const GAS u32x2*)((const bf16*)(F.ws + WS_XN) + (tok0_ + t4) * DM) + lane; _Pragma("unroll") for (int j = 0; j < 4; ++j) hraw[t4][j] = xr[64 * j]; } } while (0)
    FK_ROUTE_LOAD(0);
    for (int q = 0; q < 4; ++q) {
        const int tl0 = F.wave * 16 + q * 4; const size_t tok0 = (size_t)F.bid * 128 + tl0;
        f32x4 v[4][4]; float rs[4];
#pragma unroll
        for (int t4 = 0; t4 < 4; ++t4)
#pragma unroll
            for (int j = 0; j < 4; ++j) { const u32x2 hb = hraw[t4][j]; v[t4][j] = (f32x4){bf_lo(hb.x), bf_hi(hb.x), bf_lo(hb.y), bf_hi(hb.y)}; }
        if (q < 3) FK_ROUTE_LOAD(q + 1);
#pragma unroll
        for (int t4 = 0; t4 < 4; ++t4) { float s = 0.f;
#pragma unroll
            for (int j = 0; j < 4; ++j) s += (v[t4][j].x * v[t4][j].x + v[t4][j].y * v[t4][j].y) + (v[t4][j].z * v[t4][j].z + v[t4][j].w * v[t4][j].w);
            rs[t4] = 1.0f / sqrtf(wave_sum(s) * (1.f / DM) + EPS); }
        float lg[32];
        f32x2_t lg2[4][4];
#pragma unroll
        for (int t4 = 0; t4 < 4; ++t4)
#pragma unroll
            for (int k = 0; k < 4; ++k) lg2[t4][k] = (f32x2_t){0.f, 0.f};
#pragma unroll
        for (int j = 0; j < 4; ++j) { const f32x4 gg = ggv[j];
#pragma unroll
            for (int t4 = 0; t4 < 4; ++t4) { v[t4][j] = (f32x4){v[t4][j].x * rs[t4] * gg.x, v[t4][j].y * rs[t4] * gg.y, v[t4][j].z * rs[t4] * gg.z, v[t4][j].w * rs[t4] * gg.w};
                ((GAS unsigned*)(XN3 + (tok0 + t4) * DM) + lane)[64 * j] = pk4_fp8(v[t4][j].x, v[t4][j].y, v[t4][j].z, v[t4][j].w); }
            const int k0 = (64 * j + lane) * 4;
#pragma unroll
            for (int c = 0; c < 4; ++c) { const f32x4 r0 = *(const LAS f32x4*)(rt + (k0 >> 2) * 36 + c * 8), r1 = *(const LAS f32x4*)(rt + (k0 >> 2) * 36 + c * 8 + 4);
#pragma unroll
                for (int t4 = 0; t4 < 4; ++t4) { const float xv = v[t4][j][c]; const f32x2_t x2 = (f32x2_t){xv, xv};
                    lg2[t4][0] = __builtin_elementwise_fma(x2, (f32x2_t){r0[0], r0[1]}, lg2[t4][0]); lg2[t4][1] = __builtin_elementwise_fma(x2, (f32x2_t){r0[2], r0[3]}, lg2[t4][1]);
                    lg2[t4][2] = __builtin_elementwise_fma(x2, (f32x2_t){r1[0], r1[1]}, lg2[t4][2]); lg2[t4][3] = __builtin_elementwise_fma(x2, (f32x2_t){r1[2], r1[3]}, lg2[t4][3]); } } }
#pragma unroll
        for (int t4 = 0; t4 < 4; ++t4)
#pragma unroll
            for (int k = 0; k < 4; ++k) { lg[t4 * 8 + 2 * k] = lg2[t4][k].x; lg[t4 * 8 + 2 * k + 1] = lg2[t4][k].y; }
        {
            const bool b5 = (lane & 32) != 0;
#pragma unroll
            for (int i = 0; i < 16; ++i) { const float send = b5 ? lg[i] : lg[16 + i]; const float keep = b5 ? lg[16 + i] : lg[i]; lg[i] = keep + __shfl_xor(send, 32); }
            const bool b4 = (lane & 16) != 0;
#pragma unroll
            for (int i = 0; i < 8; ++i) { const float send = b4 ? lg[i] : lg[8 + i]; const float keep = b4 ? lg[8 + i] : lg[i]; lg[i] = keep + __shfl_xor(send, 16); }
            const bool b3 = (lane & 8) != 0;
#pragma unroll
            for (int i = 0; i < 4; ++i) { const float send = b3 ? lg[i] : lg[4 + i]; const float keep = b3 ? lg[4 + i] : lg[i]; lg[i] = keep + __shfl_xor(send, 8); }
            const bool b2 = (lane & 4) != 0;
#pragma unroll
            for (int i = 0; i < 2; ++i) { const float send = b2 ? lg[i] : lg[2 + i]; const float keep = b2 ? lg[2 + i] : lg[i]; lg[i] = keep + __shfl_xor(send, 4); }
            const bool b1 = (lane & 2) != 0;
            { const float send = b1 ? lg[0] : lg[1]; const float keep = b1 ? lg[1] : lg[0]; lg[0] = keep + __shfl_xor(send, 2); }
            lg[0] += __shfl_xor(lg[0], 1);
        }
        float l8[8];
#pragma unroll
        for (int e = 0; e < 8; ++e) l8[e] = __shfl(lg[0], (lane & 48) + 2 * e);
        if ((lane & 15) == 0) {
            const int tl = tl0 + (lane >> 4);
            int e0 = 0; float b0 = l8[0];
#pragma unroll
            for (int e = 1; e < 8; ++e) if (l8[e] > b0) { b0 = l8[e]; e0 = e; }
            int e1 = 0; float b1v = -INFINITY;
#pragma unroll
            for (int e = 0; e < 8; ++e) if (e != e0 && l8[e] > b1v) { b1v = l8[e]; e1 = e; }
            const float p1 = __expf(b1v - b0); const float g0 = 1.0f / (1.0f + p1), g1 = p1 / (1.0f + p1);
            te[tl * 2] = e0; te[tl * 2 + 1] = e1; tg[tl * 2] = g0; tg[tl * 2 + 1] = g1;
            trank[tl * 2] = (int)__hip_atomic_fetch_add(lcnt + e0, 1u, __ATOMIC_RELAXED, __HIP_MEMORY_SCOPE_WORKGROUP);
            trank[tl * 2 + 1] = (int)__hip_atomic_fetch_add(lcnt + e1, 1u, __ATOMIC_RELAXED, __HIP_MEMORY_SCOPE_WORKGROUP);
        }
    }
#undef FK_ROUTE_LOAD
    __syncthreads();
    if (tid < 8) lbase[tid] = __hip_atomic_fetch_add(F.ctl + CW_ECNT + 64 * tid, lcnt[tid], RLX_AGENT);
}
struct MoeGeom { int pend[8]; int npanels; };
DI MoeGeom moe_geom(Frame& F) {
    MoeGeom mg; int acc = 0;
#pragma unroll
    for (int e = 0; e < 8; ++e) { const unsigned c = __hip_atomic_load(F.ctl + CW_ECNT + 64 * e, RLX_AGENT); acc += (int)((c + 255u) >> 8); mg.pend[e] = acc; }
    mg.npanels = acc; return mg;
}
DI void route_phase_b(Frame& F, const MoeGeom& mg) {
    const int tid = (F.wave * 64 + lane_id());
    LAS int* te = (LAS int*)(F.lds + RL_TE); LAS float* tg = (LAS float*)(F.lds + RL_TG); LAS int* trank = (LAS int*)(F.lds + RL_RANK); LAS unsigned* lbase = (LAS unsigned*)(F.lds + RL_BASE);
    gu32* slot_tok = F.ctl + CW_SLOT_TOK; GAS float* slot_gate = (GAS float*)(F.ctl + CW_SLOT_GATE);
    for (int idx = tid; idx < 256; idx += NTHR) { const int e = te[idx]; int pstart = 0;
#pragma unroll
        for (int x = 0; x < 7; ++x) if (e > x) pstart = mg.pend[x];
        const int slot = pstart * 256 + (int)lbase[e] + trank[idx];
        const unsigned tk = (unsigned)(F.bid * 128 + (idx >> 1)) * 2u + (unsigned)(idx & 1);
        slot_tok[slot] = tk + 1u; slot_gate[slot] = tg[idx]; }
}
template <int NTILE, bool GATHERED> struct MoeOrder {
    int cp0, cpn, xp0, xpn, G, c, nskip; const volatile LAS unsigned char* pe;
    DI bool next(int k, Unit& u) const {
        int pl, pn;
        if ((NTILE & 3) == 0 && G == 256 && (cpn & 7) == 0) {
            const int x = c & 7, j = c >> 3, sk = (nskip + 7 - x) >> 3;
            const int i = k + ((j < sk) ? 3 : 0);
            const int q = (i < 3) ? i * (32 - sk) + (j - sk) : 3 * (32 - sk) + (i - 3) * 32 + j;
            const int B = (q >> 5) * 8 + x, jj = q & 31, nmain = (cpn >> 3) * (NTILE / 4);
            if (B < nmain) { const int pg = B / (NTILE / 4), tg = B - pg * (NTILE / 4); pl = pg * 8 + (jj & 7); pn = tg * 4 + (jj >> 3); }
            else { const int uu = (B - nmain) * 32 + jj; if (uu >= xpn * NTILE) return false; pn = uu / xpn; pl = cpn + (uu - pn * xpn); }
        } else {
            const unsigned np = (unsigned)(cpn + xpn); unsigned L;
            if (nskip == 0) L = (unsigned)k * (unsigned)G + (unsigned)c;
            else { const int i = k + ((c < nskip) ? 3 : 0); L = (i < 3) ? (unsigned)(i * (G - nskip) + (c - nskip)) : (unsigned)(3 * (G - nskip) + (i - 3) * G + c); }
            if (L >= np * (unsigned)NTILE) return false;
            pn = (int)(L / np); pl = (int)(L - (unsigned)pn * np);
        }
        const int panel = (pl < cpn) ? cp0 + pl : xp0 + (pl - cpn); const int e = __builtin_amdgcn_readfirstlane((int)pe[panel]);
        u.pm = GATHERED ? panel : pl; u.pn = e * NTILE + pn; u.om = pl; u.on = pn; u.ex = e; return true;
    }
};
struct MoeTailOrder {
    int ndn, c, xp0; const volatile LAS unsigned char* pe;
    DI bool next(int k, Unit& u) const {
        if (k > 0 || c >= ndn) return false;
        const int j = c >> 2, tile = c & 3; const int e = __builtin_amdgcn_readfirstlane((int)pe[xp0 + j]);
        u.pm = 128 + j; u.pn = e * 4 + tile; u.om = 128 + j; u.on = tile; u.ex = e; return true;
    }
};
DI void final_phase(Frame& F, const Args& A) {
    const int lane = (F.wave * 64 + lane_id()) & 63;
    const int gw = F.bid * NWAVES + F.wave, NGW = F.G * NWAVES; const float* g = A.in[I_FINAL_NORM];
    const bf16* H = (const bf16*)(F.ws + WS_XN); const bf16* Y0 = (const bf16*)(F.ws + WS_Y0); const bf16* Y1 = (const bf16*)(F.ws + WS_Y1);
    const GAS f32x4* gr = (const GAS f32x4*)g + lane;
    f32x4 gg[4];
#pragma unroll
    for (int j = 0; j < 4; ++j) gg[j] = gr[64 * j];
    u32x2 hb[4], ya[4], yb[4];
#define FK_FIN_LOAD(m_) do { const GAS u32x2* hr_ = (const GAS u32x2*)(H + (size_t)(m_) * DM) + lane; const GAS u32x2* y0_ = (const GAS u32x2*)(Y0 + (size_t)(m_) * DM) + lane; const GAS u32x2* y1_ = (const GAS u32x2*)(Y1 + (size_t)(m_) * DM) + lane; \
        _Pragma("unroll") for (int j = 0; j < 4; ++j) { hb[j] = __builtin_nontemporal_load((const u32x2*)(hr_ + 64 * j)); ya[j] = __builtin_nontemporal_load((const u32x2*)(y0_ + 64 * j)); yb[j] = __builtin_nontemporal_load((const u32x2*)(y1_ + 64 * j)); } } while (0)
#ifndef FIN_PREFETCH
#define FIN_PREFETCH 1
#endif
    if (FIN_PREFETCH && gw < T) FK_FIN_LOAD(gw);
    for (int m = gw; m < T; m += NGW) {
        if (!FIN_PREFETCH) FK_FIN_LOAD(m);
        GAS f32x4* xr = (GAS f32x4*)(F.out + (size_t)m * DM) + lane;
        f32x4 v[4]; float s = 0.f;
#pragma unroll
        for (int j = 0; j < 4; ++j) { const u32x2 h2 = hb[j], a = ya[j], b = yb[j];
            v[j].x = bf_lo(h2.x) + bf_lo(a.x) + bf_lo(b.x); v[j].y = bf_hi(h2.x) + bf_hi(a.x) + bf_hi(b.x); v[j].z = bf_lo(h2.y) + bf_lo(a.y) + bf_lo(b.y); v[j].w = bf_hi(h2.y) + bf_hi(a.y) + bf_hi(b.y);
            s += (v[j].x * v[j].x + v[j].y * v[j].y) + (v[j].z * v[j].z + v[j].w * v[j].w); }
        if (FIN_PREFETCH && m + NGW < T) FK_FIN_LOAD(m + NGW);
        const float rs = 1.0f / sqrtf(wave_sum(s) * (1.f / DM) + EPS);
#pragma unroll
        for (int j = 0; j < 4; ++j) __builtin_nontemporal_store((f32x4){v[j].x * rs * gg[j].x, v[j].y * rs * gg[j].y, v[j].z * rs * gg[j].z, v[j].w * rs * gg[j].w}, (f32x4*)(xr + 64 * j));
    }
#undef FK_FIN_LOAD
}

#ifndef RET_NO_LOOKAHEAD
#define RET_NO_LOOKAHEAD 0
#endif
constexpr int N_PHASES = 16;
__global__ void __launch_bounds__(NTHR, 2) mega_fwd(Args args) {
    extern __shared__ __attribute__((aligned(16))) unsigned char lds_raw[];
    Frame F;
    F.lds = (LAS unsigned char*)lds_raw; F.MISC = (volatile LAS unsigned*)(F.lds + MISC_OFF);
    F.wave = __builtin_amdgcn_readfirstlane((int)threadIdx.x >> 6); F.G = gridDim.x; F.bid = blockIdx.x;
    F.ws = args.ws; F.ctl = (gu32*)(args.ws + WS_CTL); F.out = args.out;
    const Args& A = args;
    if ((F.wave * 64 + lane_id()) < 32) F.MISC[(F.wave * 64 + lane_id())] = 0u;
    __syncthreads();
    XcdBarrier bar = xcd_barrier_post((unsigned*)(F.ctl + CW_BAR) + args.li * XCD_BAR_WORDS, F.MISC + 8);
    const int lo = args.ph_lo, hi = args.ph_hi;
#define IN(k) (lo <= (k) && (k) < hi)
#ifdef PROBE_MASK
    volatile LAS unsigned long long* tsv = (volatile LAS unsigned long long*)(F.lds + MISC_OFF + 256);
#define TSTAMP(i) do { if (F.bid == 0 && (F.wave * 64 + lane_id()) == 0) tsv[i] = __builtin_amdgcn_s_memrealtime(); } while (0)
#define TACC(i, a, b) do { if (F.bid == 0 && (F.wave * 64 + lane_id()) == 0) tsv[i] += tsv[b] - tsv[a]; } while (0)
    if (F.bid == 0 && (F.wave * 64 + lane_id()) == 0) { tsv[30] = 0ull; tsv[31] = 0ull; tsv[23] = 0ull; tsv[24] = 0ull; tsv[25] = 0ull; }
#ifndef PROBE_EPI_PHASE
#define PROBE_EPI_PHASE 99
#endif
#define EPI_ON(k) do { if (F.bid == 0 && (F.wave * 64 + lane_id()) == 0) tsv[23] = ((k) == PROBE_EPI_PHASE) ? 1ull : 0ull; } while (0)
#else
#define TSTAMP(i) do {} while (0)
#define TACC(i, a, b) do {} while (0)
#define EPI_ON(k) do {} while (0)
#endif
#ifdef PROBE_MASK
#define UNIT_T0(cond) unsigned long long _ut0 = 0ull; if (cond) _ut0 = __builtin_amdgcn_s_memrealtime();
#define UNIT_A0 const unsigned long long _ua0 = __builtin_amdgcn_s_memrealtime();
#define UNIT_A1(slot) if (F.bid == 0) { const unsigned long long _ua1 = __builtin_amdgcn_s_memrealtime(); if ((F.wave * 64 + lane_id()) == 0) __hip_atomic_fetch_add(F.ctl + CW_PROBE + (slot), (unsigned)(_ua1 - _ua0), RLX_AGENT); }
#ifdef PROBE_RETSEG
#define UNIT_T1(cond, slot) if (false) {}
#else
#define UNIT_T1(cond, slot) if (cond) { const unsigned long long _ut1 = __builtin_amdgcn_s_memrealtime(); if ((F.wave * 64 + lane_id()) == 0) __hip_atomic_store(F.ctl + CW_PROBE + (slot), (unsigned)(_ut1 - _ut0), RLX_AGENT); }
#endif
#else
#define UNIT_T0(cond)
#define UNIT_T1(cond, slot)
#define UNIT_A0
#define UNIT_A1(slot)
#endif
#define SEAM(k) do { if (IN(k) && IN((k) + 1)) xcd_barrier(bar); TSTAMP((k) + 1); } while (0)
    TSTAMP(0);
    unsigned char* ws = F.ws;
    float* SSQ = (float*)(ws + WS_SSQ);
    bf16* XN = (bf16*)(ws + WS_XN); bf16* P = (bf16*)(ws + WS_P); bf16* Qb = (bf16*)(ws + WS_Q); bf16* KVH = (bf16*)F.out;        bf16* MIX = (bf16*)(ws + WS_MIXED);
    bf16* HACT = (bf16*)(ws + WS_HACT); bf16* P2 = (bf16*)(ws + WS_P2); bf16* MIX2 = (bf16*)(ws + WS_MIXED2); unsigned char* MACT = ws + WS_MACT; unsigned char* XN3 = (unsigned char*)F.out + XN3_OUT_OFF; bf16* Y0 = (bf16*)(ws + WS_Y0); bf16* Y1 = (bf16*)(ws + WS_Y1);

    if (IN(0)) prologue_phase(F, A);
    SEAM(0);
    EPI_ON(1);
    if (IN(1)) { Gemm g{XN, (const bf16*)(ws + WS_W_ABIN), 1024, 1024, 1024, nullptr}; pg8::StaticOrder S; S.init(T, AB_P, F.G, F.bid); EpiP E{P, (const float2*)(ws + WS_CS32), (const float2*)(ws + WS_CS16), SSQ, F.lds, (const float*)(ws + WS_SSQX)};
        pg8::gemm_phase<EpiP, pg8::StaticOrder, false>(F.lds, g, S, E, F.wave);
        late_conv_drain(F, A); }
    SEAM(1);
    TSTAMP(3);
    if (IN(3)) {
        { Gemm g{P + PC_QLAT, (const bf16*)(ws + WS_W_UQ), AB_P, 384, 384, nullptr}; pg8::StaticOrder S; S.init(T, 768, F.G, F.bid); EpiQ E{Qb, (const float2*)(ws + WS_CS16), SSQ, F.lds};
          pg8::gemm_phase<EpiQ, pg8::StaticOrder, false>(F.lds, g, S, E, F.wave); }
        { Gemm g{P + PC_KVLAT, (const bf16*)(ws + WS_W_UKV), AB_P, 256, 256, nullptr}; pg8::StaticOrder S; S.init(T, 1024, F.G, F.bid); EpiKvh E{KVH, SSQ, F.lds};
          pg8::gemm_phase<EpiKvh, pg8::StaticOrder, false>(F.lds, g, S, E, F.wave); }
    }
    SEAM(3);
#ifdef PROBE_P4X
    _Pragma("unroll") for (int _rx = 0; _rx < PROBE_P4X; ++_rx) {
        xcd_barrier(bar); if (F.bid == 0 && (F.wave * 64 + lane_id()) == 0) __hip_atomic_store(F.ctl + CW_QUEUE + 64 * 0, 0u, RLX_AGENT); xcd_barrier(bar);
#else
    {
#endif
    if (IN(4)) {
        for (int it = queue_first(F, 0); it < 128 + 1024; ) { const bool la = RET_NO_LOOKAHEAD ? (it >= 128) : true; unsigned nxq = 0u; if (la) nxq = queue_post(F, 0);
            UNIT_T0(it == 0 || it == 128 || it == 128 + 1023) UNIT_A0
            if (it < 128) ret_unit(F, it >> 3, it & 7, P, A.in[I_RET_GN], MIX);
            else { const int j = it - 128; const int qb = 7 - (j >> 7), bh = j & 127; mla_unit(F, bh >> 3, bh & 7, qb, Qb, KVH, P, MIX); }
            UNIT_T1(it == 0, 0) UNIT_T1(it == 128, 1) UNIT_T1(it == 128 + 1023, 2) UNIT_A1(7)
            it = la ? queue_take(F, nxq, 0) : queue_first(F, 0); }
    }
    }
    SEAM(4);
    EPI_ON(5);
#if OUTPROJ_FP8
    if (IN(5)) { Gemm g{MIX, (const bf16*)(ws + WS_W_ABOUT), 768, 768, 768, nullptr}; pg8::StaticOrder S; S.init(T, 1024, F.G, F.bid); EpiResidNormT<true> E{nullptr, XN, SSQ, W8_INV * MIX_INV, F.lds, 0};
        pg8::gemm_phase<EpiResidNormT<true>, pg8::StaticOrder, false, true>(F.lds, g, S, E, F.wave); }
#else
    if (IN(5)) { Gemm g{MIX, (const bf16*)(ws + WS_W_ABOUT), 1536, 1536, 1536, nullptr}; pg8::StaticOrder S; S.init(T, 1024, F.G, F.bid); EpiResidNormT<true> E{nullptr, XN, SSQ, 1.0f, F.lds, 0};
        pg8::gemm_phase<EpiResidNormT<true>, pg8::StaticOrder, false>(F.lds, g, S, E, F.wave); }
#endif
    SEAM(5);
    EPI_ON(7);
#if FFN_FP8
    if (IN(6)) { norm8_phase(F, A.in[I_FFN_NORM], (unsigned char*)XN); moe_conv_phase(F, A); }
    SEAM(6);
    if (IN(7)) { Gemm g{XN, (const bf16*)(ws + WS_W_FGU), 512, 512, 512, nullptr}; pg8::StaticOrder S; S.init(T, 7168, F.G, F.bid); EpiSwiglu8 E{(unsigned char*)HACT};
        pg8::gemm_phase<EpiSwiglu8, pg8::StaticOrder, false, true>(F.lds, g, S, E, F.wave); }
    SEAM(7);
    if (IN(8)) { Gemm g{HACT, (const bf16*)(ws + WS_W_FD), FF / 2, FF / 2, FF / 2, nullptr}; pg8::StaticOrder S; S.init(T, 1024, F.G, F.bid); EpiResid E{F.out, F.out, W8_INV};
        pg8::gemm_phase<EpiResid, pg8::StaticOrder, false, true>(F.lds, g, S, E, F.wave); }
#else
    TSTAMP(7);
#if FFN_DOWN_FP8
    if (IN(7)) { moe_conv_phase(F, A); __syncthreads();
#ifdef PROBE_MCX
        for (int _mx = 0; _mx < PROBE_MCX; ++_mx) { moe_conv_phase(F, A); __syncthreads(); }
#endif
        Gemm g{XN, (const bf16*)(ws + WS_W_FGU), 1024, 1024, 1024, nullptr}; pg8::StaticOrder S; S.init(T, 7168, F.G, F.bid); EpiSwigluO8 E{HACT, SSQ, F.lds};
        pg8::gemm_phase<EpiSwigluO8, pg8::StaticOrder, false>(F.lds, g, S, E, F.wave);
#ifdef PROBE_P7X
#pragma unroll 1
        for (int _px = 0; _px < PROBE_P7X; ++_px) { xcd_barrier(bar); pg8::gemm_phase<EpiSwigluO8, pg8::StaticOrder, false>(F.lds, g, S, E, F.wave); }
#endif
        }
    SEAM(7);
    EPI_ON(8);
    if (IN(8)) { Gemm g{HACT, (const bf16*)(ws + WS_W_FD), FF / 2, FF / 2, FF / 2, nullptr}; pg8::StaticOrder S; S.init(T, 1024, F.G, F.bid); EpiResidNormT<true> E{nullptr, XN, SSQ, W8_INV, F.lds, 0};
        pg8::gemm_phase<EpiResidNormT<true>, pg8::StaticOrder, false, true>(F.lds, g, S, E, F.wave); }
#else
    if (IN(7)) { Gemm g{XN, (const bf16*)(ws + WS_W_FGU), 1024, 1024, 1024, nullptr}; pg8::StaticOrder S; S.init(T, 7168, F.G, F.bid); EpiSwiglu E{HACT, SSQ, F.lds};
        pg8::gemm_phase<EpiSwiglu, pg8::StaticOrder, false>(F.lds, g, S, E, F.wave); }
    SEAM(7);
    EPI_ON(8);
    if (IN(8)) { Gemm g{HACT, (const bf16*)(ws + WS_W_FD), FF, FF, FF, nullptr}; pg8::StaticOrder S; S.init(T, 1024, F.G, F.bid); EpiResidNormT<true> E{nullptr, XN, SSQ, 1.0f, F.lds, 0};
        pg8::gemm_phase<EpiResidNormT<true>, pg8::StaticOrder, false>(F.lds, g, S, E, F.wave); }
#endif
#endif
    SEAM(8);
    TSTAMP(10);
    EPI_ON(10);
    if (IN(10)) { Gemm g{XN, (const bf16*)(ws + WS_W_CDIN), 1024, 1024, 1024, nullptr}; pg8::StaticOrder S; S.init(T, CD_IN, F.G, F.bid); EpiBf16R E{P2, CD_IN, SSQ, F.lds};
        pg8::gemm_phase<EpiBf16R, pg8::StaticOrder, false>(F.lds, g, S, E, F.wave);
        moe_conv_tail_drain(F, A); }
    SEAM(10);
#ifdef PROBE_P11X
    _Pragma("unroll") for (int _rx = 0; _rx < PROBE_P11X; ++_rx) {
        xcd_barrier(bar); if (F.bid == 0 && (F.wave * 64 + lane_id()) == 0) __hip_atomic_store(F.ctl + CW_QUEUE + 64 * 1, 0u, RLX_AGENT); xcd_barrier(bar);
#else
    {
#endif
    if (IN(11)) {
        for (int it = queue_first(F, 1); it < 1024 + 512; ) { const unsigned nxq = queue_post(F, 1);
            UNIT_T0(it == 0 || it == 512 || it == 1535) UNIT_A0
            if (it >= 512) { const int j = it - 512; const int qb = 7 - (j >> 7), bh = j & 127; sb_unit(F, bh >> 3, bh & 7, qb, P2, MIX2); }
            else { swa_unit(F, it >> 5, (it >> 4) & 1, it & 15, P2, A.in[I_SINKS], MIX2); }
            UNIT_T1(it == 512, 3) UNIT_T1(it == 1535, 4) UNIT_T1(it == 0, 5) UNIT_A1(6)
            it = queue_take(F, nxq, 1); }
    }
    }
    SEAM(11);
    EPI_ON(12);
#if OUTPROJ2_FP8
    if (IN(12)) { Gemm g{MIX2, (const bf16*)(ws + WS_W_CDOUT), 768, 768, 768, nullptr}; pg8::StaticOrder S; S.init(T, 1024, F.G, F.bid); EpiResidB16 E{XN, W8_INV * MIX_INV};
        pg8::gemm_phase<EpiResidB16, pg8::StaticOrder, false, true>(F.lds, g, S, E, F.wave); }
#else
    if (IN(12)) { Gemm g{MIX2, (const bf16*)(ws + WS_W_CDOUT), 1536, 1536, 1536, nullptr}; pg8::StaticOrder S; S.init(T, 1024, F.G, F.bid); EpiResidB16 E{XN, 1.0f};
        pg8::gemm_phase<EpiResidB16, pg8::StaticOrder, false>(F.lds, g, S, E, F.wave); }
#endif
    SEAM(12);
    if (IN(13)) { route_phase_a(F, A); xcd_barrier(bar); const MoeGeom mg = moe_geom(F); route_phase_b(F, mg); }
    SEAM(13);
    EPI_ON(14);
    if (IN(14)) {
        int npanels;
        {
            const MoeGeom mg = moe_geom(F); npanels = mg.npanels;
            volatile LAS unsigned char* pe = (volatile LAS unsigned char*)(F.lds + MISC_OFF + 512);
            for (int pnl = (F.wave * 64 + lane_id()); pnl < 272; pnl += NTHR) { int e = 0;
#pragma unroll
                for (int x = 0; x < 7; ++x) if (pnl >= mg.pend[x]) e = x + 1;
                pe[pnl] = (unsigned char)e; }
            __syncthreads();
        }
        const unsigned* slot_tok = (const unsigned*)(F.ctl + CW_SLOT_TOK); const float* slot_gate = (const float*)(F.ctl + CW_SLOT_GATE);
        const volatile LAS unsigned char* pe = (const volatile LAS unsigned char*)(F.lds + MISC_OFF + 512);
        const int tailp = npanels > 2 * CHUNK_PANELS ? npanels - 2 * CHUNK_PANELS : 0, ndn = 4 * tailp;
#ifdef PROBE_MOEX
        for (int c2 = 0; c2 < 2 * (1 + PROBE_MOEX); ++c2) { const int c = c2 & 1;
#else
        for (int c = 0; c < 2; ++c) {
#endif
            const int cp0 = c * CHUNK_PANELS, cpn = (npanels - cp0) < CHUNK_PANELS ? (npanels - cp0) : CHUNK_PANELS;
            TSTAMP(20);
            if (c == 1 && ndn > 0) { MoeTailOrder S{ndn, F.bid, 2 * CHUNK_PANELS, pe};
              Gemm g{(const bf16*)MACT, (const bf16*)(ws + WS_MOEW_D), FF / 2, FF / 2, FF / 2, nullptr}; EpiMoeDown E{Y0, (long long)(WS_Y1 - WS_Y0) / 2, slot_tok, slot_gate, (2 * CHUNK_PANELS - 128) * 256};
              pg8::gemm_phase<EpiMoeDown, MoeTailOrder, false, true>(F.lds, g, S, E, F.wave); }
            { MoeOrder<28, true> S{cp0, cpn, 2 * CHUNK_PANELS, c == 0 ? tailp : 0, F.G, F.bid, c == 1 ? ndn : 0, pe};
              Gemm g{(const bf16*)XN3, (const bf16*)(ws + WS_MOEW_GU), 512, 512, 512, slot_tok}; EpiSwiglu8 E{MACT};
              pg8::gemm_phase<EpiSwiglu8, MoeOrder<28, true>, true, true>(F.lds, g, S, E, F.wave); }
            xcd_barrier(bar); TSTAMP(21); TACC(30, 20, 21);
            { MoeOrder<4, false> S{cp0, cpn, 0, 0, F.G, F.bid, 0, pe};
              Gemm g{(const bf16*)MACT, (const bf16*)(ws + WS_MOEW_D), FF / 2, FF / 2, FF / 2, nullptr}; EpiMoeDown E{Y0, (long long)(WS_Y1 - WS_Y0) / 2, slot_tok, slot_gate, cp0 * 256};
              pg8::gemm_phase<EpiMoeDown, MoeOrder<4, false>, false, true>(F.lds, g, S, E, F.wave); }
            xcd_barrier(bar); TSTAMP(22); TACC(31, 21, 22);
        }
    }
#ifdef PROBE_BARX
    for (int _bx = 0; _bx < PROBE_BARX; ++_bx) xcd_barrier(bar);
#endif
    TSTAMP(15);
    if (IN(15)) final_phase(F, A);
#ifdef PROBE_FINX
    for (int _fx = 0; _fx < PROBE_FINX; ++_fx) { xcd_barrier(bar); final_phase(F, A); }
#endif
#ifdef PROBE_MASK
    xcd_barrier(bar);
    if (F.bid == 0 && (F.wave * 64 + lane_id()) == 0) {
        const unsigned long long tend = __builtin_amdgcn_s_memrealtime(); tsv[16] = tend; unsigned long long D = 0ull;
        for (int k = 0; k < 16; ++k) if ((PROBE_MASK >> k) & 1) D += tsv[k + 1] - tsv[k];
        if ((PROBE_MASK >> 16) & 1) D += tsv[30];
        if ((PROBE_MASK >> 17) & 1) D += tsv[31];
        if ((PROBE_MASK >> 26) & 1) D += tsv[24];
        if ((PROBE_MASK >> 27) & 1) D += tsv[25];
        for (int k = 0; k < 8; ++k) if ((PROBE_MASK >> (18 + k)) & 1) D += (unsigned long long)__hip_atomic_load(F.ctl + CW_PROBE + k, RLX_AGENT);
        const unsigned long long until = tend + (unsigned long long)PROBE_MULT * D;
        while (__builtin_amdgcn_s_memrealtime() < until) __builtin_amdgcn_s_sleep(8);
    }
#endif
#undef IN
#undef SEAM
}

static int g_grid = 0;
static inline int host_setup(size_t ws_size) {
    if (g_grid) return g_grid;
    if (ws_size < WS_END) { fprintf(stderr, "kernel_launch: workspace too small: %zu < %zu\n", ws_size, (size_t)WS_END); g_grid = -1; return -1; }
    int dev = 0, cus = 0, per_cu = 0;
    if (hipGetDevice(&dev) != hipSuccess || hipDeviceGetAttribute(&cus, hipDeviceAttributeMultiprocessorCount, dev) != hipSuccess) { g_grid = -1; return -1; }
    if (hipFuncSetAttribute((const void*)mega_fwd, hipFuncAttributeMaxDynamicSharedMemorySize, LDS_BYTES) != hipSuccess) { fprintf(stderr, "kernel_launch: hipFuncSetAttribute failed\n"); g_grid = -1; return -1; }
    if (hipOccupancyMaxActiveBlocksPerMultiprocessor(&per_cu, (const void*)mega_fwd, NTHR, LDS_BYTES) != hipSuccess || per_cu < 1) fprintf(stderr, "kernel_launch: occupancy query says %d blocks per CU\n", per_cu);
    (void)hipGetLastError();
    if (cus != 256) fprintf(stderr, "kernel_launch: %d CUs (built for 256)\n", cus);
    g_grid = 256;
    return g_grid;
}
static inline void launch_range(const Args& a0, int lo, int hi, int li, hipStream_t stream) {
    Args a = a0; a.ph_lo = lo; a.ph_hi = hi; a.li = li;
    hipLaunchKernelGGL(mega_fwd, dim3(g_grid), dim3(NTHR), LDS_BYTES, stream, a);
}
}


extern "C" void kernel_launch(void* const* d_in, const int* in_sizes, int n_in, void* d_out, int out_size, void* d_ws, size_t ws_size, hipStream_t stream) {
    if (fk::host_setup(ws_size) < 0) return;
    if (hipMemsetAsync((char*)d_ws + fk::WS_CTL, 0, fk::CTL_ZERO_BYTES, stream) != hipSuccess) return;
    fk::Args a{};
    for (int i = 0; i < 23; ++i) a.in[i] = (const float*)d_in[i];
    a.out = (float*)d_out; a.ws = (unsigned char*)d_ws;
    fk::launch_range(a, 0, fk::N_PHASES, 0, stream);
}
```
